# Optimizing an MI355X kernel written in HIP

```python
import numpy as np
import jax
import jax.numpy as jnp
from jax import lax

D_MODEL = 1024
BATCH = 2
SEQ = 8192
DEPTH = 2

HEAD_DIM = 64
MIX_WIDTH = D_MODEL
N_HEADS_DIL = (MIX_WIDTH // 2) // HEAD_DIM
DIL_CONFIGS = ((128, 1), (512, 4), (2048, 16))
N_HEADS_MLA = (MIX_WIDTH // 2) // HEAD_DIM
MLA_NOPE = HEAD_DIM
MLA_ROPE = HEAD_DIM // 2
MLA_V = HEAD_DIM
Q_LORA = D_MODEL // 4
KV_LORA = D_MODEL // 8
D_FF = 4 * D_MODEL
ROPE_THETA = 10000.0
EPS = 1e-6
Q_BLOCK = 128
NEG_INF = -1e30
IN_SPLITS = (N_HEADS_DIL * HEAD_DIM, N_HEADS_DIL * HEAD_DIM, N_HEADS_DIL * HEAD_DIM, Q_LORA, KV_LORA, MLA_ROPE)
W_IN_COLS = sum(IN_SPLITS)

kernel_name = 'hybrid_dilated_mla_adaln_encoder'


def rms_norm(x, g):
    xf = x.astype(jnp.float32)
    y = xf * lax.rsqrt(jnp.mean(xf * xf, axis=-1, keepdims=True) + EPS)
    return (y * g.astype(jnp.float32)).astype(x.dtype)


def alibi_slopes(n):
    return jnp.asarray([2.0 ** (-8.0 * (h + 1) / n) for h in range(n)], dtype=jnp.float32)


def rope(x, pos):
    half = x.shape[-1] // 2
    inv = ROPE_THETA ** (-jnp.arange(half, dtype=jnp.float32) / half)
    ang = pos.astype(jnp.float32)[..., None] * inv
    ang = ang.reshape(ang.shape[:2] + (1,) * (x.ndim - 3) + (half,))
    cos, sin = jnp.cos(ang), jnp.sin(ang)
    xf = x.astype(jnp.float32)
    x1, x2 = xf[..., :half], xf[..., half:]
    return jnp.concatenate([x1 * cos - x2 * sin, x2 * cos + x1 * sin], axis=-1).astype(x.dtype)


def dilated_branch(q, k, v, pos, slopes, window, dil):
    B, S, H, Dh = q.shape
    half = window // (2 * dil)
    blk = half
    span = dil * blk
    Sp = -(-S // span) * span
    L = Sp // dil
    nb = L // blk
    pad = Sp - S

    def to_strided(a):
        a = jnp.pad(a, ((0, 0), (0, pad), (0, 0), (0, 0)))
        return a.reshape(B, L, dil, H, Dh).transpose(0, 2, 3, 1, 4)

    def band(a, axis, fill):
        pw = [(0, 0)] * a.ndim
        pw[axis] = (blk, blk)
        a = jnp.pad(a, pw, constant_values=fill)
        a = a.reshape(a.shape[:axis] + (nb + 2, blk) + a.shape[axis + 1:])
        parts = [lax.slice_in_dim(a, s, s + nb, axis=axis) for s in range(3)]
        return jnp.concatenate(parts, axis=axis + 1)

    qs, ks, vs = to_strided(q), to_strided(k), to_strided(v)
    pos_s = jnp.pad(pos, ((0, 0), (0, pad))).reshape(B, L, dil).transpose(0, 2, 1)
    val_s = (jnp.arange(Sp) < S).reshape(L, dil).T

    qb = qs.reshape(B, dil, H, nb, blk, Dh)
    kw = band(ks, 3, 0)
    vw = band(vs, 3, 0)
    pk = band(pos_s, 2, 0)
    vk = band(val_s, 1, False)
    pq = pos_s.reshape(B, dil, nb, blk)

    s = jnp.einsum('brhnid,brhnjd->brhnij', qb, kw, preferred_element_type=jnp.float32) * (Dh ** -0.5)
    dist = jnp.abs(pq[..., :, None] - pk[..., None, :]).astype(jnp.float32)
    s = s - slopes[None, None, :, None, None, None] * dist[:, :, None]
    rel = jnp.arange(3 * blk)[None, :] - blk - jnp.arange(blk)[:, None]
    mask = (jnp.abs(rel) <= half)[None] & vk[:, :, None, :]
    s = jnp.where(mask[None, :, None], s, NEG_INF)
    m = jnp.max(s, axis=-1, keepdims=True)
    p = jnp.exp(s - m)
    l = jnp.sum(p, axis=-1, keepdims=True)
    o = jnp.einsum('brhnij,brhnjd->brhnid', p, vw.astype(jnp.float32)) / l
    lse = (m + jnp.log(l))[..., 0]
    o = o.reshape(B, dil, H, L, Dh).transpose(0, 3, 1, 2, 4).reshape(B, Sp, H, Dh)[:, :S]
    lse = lse.reshape(B, dil, H, L).transpose(0, 3, 1, 2).reshape(B, Sp, H)[:, :S]
    return o, lse


def dilated_attention(q, k, v, pos, slopes):
    outs, lses = [], []
    for window, dil in DIL_CONFIGS:
        o, lse = dilated_branch(q, k, v, pos, slopes, window, dil)
        outs.append(o)
        lses.append(lse)
    wts = jax.nn.softmax(jnp.stack(lses), axis=0)
    return jnp.sum(jnp.stack(outs) * wts[..., None], axis=0)


def latent_attention(cq, ckv, k_rope, pos, g_cq, w_q_up, g_ckv, w_kv_up, g_qn, g_qr, g_kn, g_kr):
    B, S, _ = cq.shape
    H = N_HEADS_MLA
    q = (rms_norm(cq, g_cq) @ w_q_up).reshape(B, S, H, MLA_NOPE + MLA_ROPE)
    q_nope = rms_norm(q[..., :MLA_NOPE], g_qn)
    q_rot = rope(rms_norm(q[..., MLA_NOPE:], g_qr), pos)
    kv = (rms_norm(ckv, g_ckv) @ w_kv_up).reshape(B, S, H, MLA_NOPE + MLA_V)
    k_nope = rms_norm(kv[..., :MLA_NOPE], g_kn)
    v = kv[..., MLA_NOPE:]
    k_rot = rope(rms_norm(k_rope, g_kr), pos)
    scale = (MLA_NOPE + MLA_ROPE) ** -0.5
    nq = S // Q_BLOCK
    qn_b = q_nope.reshape(B, nq, Q_BLOCK, H, MLA_NOPE).transpose(1, 0, 2, 3, 4)
    qr_b = q_rot.reshape(B, nq, Q_BLOCK, H, MLA_ROPE).transpose(1, 0, 2, 3, 4)

    def block(args):
        qn, qr = args
        s = (jnp.einsum('bqhd,bkhd->bhqk', qn, k_nope, preferred_element_type=jnp.float32)
             + jnp.einsum('bqhr,bkr->bhqk', qr, k_rot, preferred_element_type=jnp.float32)) * scale
        p = jax.nn.softmax(s, axis=-1)
        return jnp.einsum('bhqk,bkhd->bqhd', p.astype(v.dtype), v)

    o = lax.map(block, (qn_b, qr_b))
    return o.transpose(1, 0, 2, 3, 4).reshape(B, S, H * MLA_V)


def setup_inputs(seed: int = 0) -> dict:
    key = jax.random.key(seed)
    k = jax.random.split(key, 21)
    Ld = DEPTH
    f32 = jnp.float32

    def nrm(i, shape, fan_in, mult=1.0):
        return jax.random.normal(k[i], shape, f32) * (mult * fan_in ** -0.5)

    def gain(i, shape):
        return 1.0 + 0.02 * jax.random.normal(k[i], shape, f32)

    x = jax.random.normal(k[0], (BATCH, SEQ, D_MODEL), f32)
    c = jax.random.normal(k[1], (BATCH, D_MODEL), f32)
    offs = jax.random.randint(k[2], (BATCH, 1), 0, 1024, dtype=jnp.int32)
    positions = jnp.arange(SEQ, dtype=jnp.int32)[None, :] + offs
    return {
        'x': x,
        'c': c,
        'positions': positions,
        'w_mod': nrm(3, (Ld, D_MODEL, 6 * D_MODEL), D_MODEL, 0.5),
        'b_mod': 0.01 * jax.random.normal(k[4], (Ld, 6 * D_MODEL), f32),
        'g_norm_mix': gain(5, (Ld, D_MODEL)),
        'w_in': nrm(6, (Ld, D_MODEL, W_IN_COLS), D_MODEL),
        'g_q_dil': gain(7, (Ld, HEAD_DIM)),
        'g_k_dil': gain(8, (Ld, HEAD_DIM)),
        'g_cq': gain(9, (Ld, Q_LORA)),
        'w_q_up': nrm(10, (Ld, Q_LORA, N_HEADS_MLA * (MLA_NOPE + MLA_ROPE)), Q_LORA),
        'g_ckv': gain(11, (Ld, KV_LORA)),
        'w_kv_up': nrm(12, (Ld, KV_LORA, N_HEADS_MLA * (MLA_NOPE + MLA_V)), KV_LORA),
        'g_q_nope': gain(13, (Ld, MLA_NOPE)),
        'g_q_rope': gain(14, (Ld, MLA_ROPE)),
        'g_k_nope': gain(15, (Ld, MLA_NOPE)),
        'g_k_rope': gain(16, (Ld, MLA_ROPE)),
        'w_out': nrm(17, (Ld, MIX_WIDTH, D_MODEL), MIX_WIDTH),
        'g_norm_mlp': gain(18, (Ld, D_MODEL)),
        'w_mlp_in': nrm(19, (Ld, D_MODEL, D_FF), D_MODEL),
        'w_mlp_out': nrm(20, (Ld, D_FF, D_MODEL), D_FF),
    }


def reference(x, c, positions, w_mod, b_mod, g_norm_mix, w_in, g_q_dil, g_k_dil, g_cq, w_q_up,
              g_ckv, w_kv_up, g_q_nope, g_q_rope, g_k_nope, g_k_rope, w_out, g_norm_mlp,
              w_mlp_in, w_mlp_out):
    B, S, _ = x.shape
    slopes = alibi_slopes(N_HEADS_DIL)
    cuts = [int(v) for v in np.cumsum(IN_SPLITS)[:-1]]
    c_act = jax.nn.silu(c)
    for l in range(DEPTH):
        mod = c_act @ w_mod[l] + b_mod[l]
        sh1, sc1, gt1, sh2, sc2, gt2 = jnp.split(mod, 6, axis=-1)

        h = rms_norm(x, g_norm_mix[l]) * (1.0 + sc1[:, None]) + sh1[:, None]
        proj = h @ w_in[l]
        q_d, k_d, v_d, cq, ckv, k_rope = jnp.split(proj, cuts, axis=-1)
        q_d = rms_norm(q_d.reshape(B, S, N_HEADS_DIL, HEAD_DIM), g_q_dil[l])
        k_d = rms_norm(k_d.reshape(B, S, N_HEADS_DIL, HEAD_DIM), g_k_dil[l])
        v_d = v_d.reshape(B, S, N_HEADS_DIL, HEAD_DIM)
        o_dil = dilated_attention(q_d, k_d, v_d, positions, slopes).reshape(B, S, -1).astype(x.dtype)
        o_mla = latent_attention(cq, ckv, k_rope, positions, g_cq[l], w_q_up[l], g_ckv[l], w_kv_up[l],
                                 g_q_nope[l], g_q_rope[l], g_k_nope[l], g_k_rope[l]).astype(x.dtype)
        mix = jnp.concatenate([o_dil, o_mla], axis=-1) @ w_out[l]
        x = x + gt1[:, None] * mix

        h = rms_norm(x, g_norm_mlp[l]) * (1.0 + sc2[:, None]) + sh2[:, None]
        y = jnp.square(jax.nn.relu(h @ w_mlp_in[l])) @ w_mlp_out[l]
        x = x + gt2[:, None] * y
    return x
```

```cpp
#include <hip/hip_runtime.h>
#include <hip/hip_cooperative_groups.h>
#include <cstdio>
#include <cstdint>
namespace cg = cooperative_groups;
namespace pg8 {
#define PG8_LAS __attribute__((address_space(3)))
typedef unsigned short bf16_t;
typedef short bf16x8 __attribute__((ext_vector_type(8)));
typedef float f32x4 __attribute__((ext_vector_type(4)));
typedef unsigned u32x4 __attribute__((ext_vector_type(4)));
constexpr int BM = 256, BK = 64, HALF = 128, HTB = HALF * BK * 2  , STAGE_BYTES = 8 * HTB, NXCD = 8, WGM = 8;

__host__ __device__ __forceinline__ int lds_byte(int r, int c) { const int st = (r >> 4) * 2 + (c >> 5), rr = r & 15, cc = c & 31, ob = rr * 64 + cc * 2; return st * 1024 + (ob ^ (((ob >> 9) & 1) << 5)); }
__host__ __device__ __forceinline__ void stage_rc(int b, int& R, int& C) { const int st = b / 1024, sb = b % 1024, swz = sb ^ (((sb >> 9) & 1) << 5); R = (st >> 1) * 16 + swz / 64; C = (st & 1) * 32 + (swz % 64) / 2; }
__host__ __device__ __forceinline__ int perm32(int rho) { const int n = rho >> 4, i = rho & 15; return 8 * (i >> 2) + 4 * n + (i & 3); }

struct Unit { int pm, pn; };
struct Gemm { const bf16_t* A; const bf16_t* Bt; int M, N, K; };

struct StaticOrder {
    int nM, nN, nwg, G, c;
    __host__ __device__ void init(int M, int N, int G_, int c_) { nM = M / BM; nN = N / BM; nwg = nM * nN; G = G_; c = c_; }
    __host__ __device__ bool next(int i, Unit& u) const {
        const long L = (long)i * G + c; if (L >= nwg) return false;
        int wgid = (int)L; { const int q = nwg / NXCD, r = nwg % NXCD, xcd = wgid % NXCD, off = wgid / NXCD; wgid = (xcd < r ? xcd * (q + 1) : r * (q + 1) + (xcd - r) * q) + off; }
        const int nig = WGM * nN, gid = wgid / nig, fm = gid * WGM, gsz = (nM - fm) < WGM ? (nM - fm) : WGM;
        u.pm = fm + ((wgid % nig) % gsz); u.pn = (wgid % nig) / gsz; return true;
    }
    __device__ __forceinline__ void a_ready(const Unit&) const {}
    __device__ __forceinline__ void done(const Unit&) const {}
};

__device__ __forceinline__ unsigned cvt_pk_bf16(float lo, float hi) { unsigned r; asm volatile("v_cvt_pk_bf16_f32 %0, %1, %2" : "=v"(r) : "v"(lo), "v"(hi)); return r; }
template <class Epi, class Sched, bool ALIGN_EPI = false, bool SP2 = false>
__device__ __forceinline__ void gemm_phase(PG8_LAS unsigned char* lds, const Gemm g, const Sched& S, const Epi& E, const int tid_in) {
    int tid_ = tid_in; asm volatile("" : "+v"(tid_));
    const int tid = tid_, wid = __builtin_amdgcn_readfirstlane(tid >> 6), lane = tid & 63, wr = wid >> 2, wc = wid & 3, fr = lane & 15, fq = lane >> 4;
    const int K = g.K, nt = K / BK;
    unsigned voffA[2], voffB[2];
#pragma unroll
    for (int i = 0; i < 2; ++i) { int R, C; stage_rc(tid * 16 + i * 8192, R, C); const int Rb = Epi::PERM ? ((R & ~31) + perm32(R & 31)) : R;
        voffA[i] = (unsigned)(R * K + C) * 2u; voffB[i] = (unsigned)(Rb * K + C) * 2u; }
    const size_t kstep = (size_t)(BK * 2);
    const size_t hstep = (size_t)HALF * K * 2;
    const size_t tstep = 2 * hstep;
    const unsigned ldsw = (unsigned)wid * 1024u;
    const int aoff = lds_byte(wr * 64 + fr, fq * 8), boff = lds_byte(wc * 32 + fr, fq * 8);
#define PG8_SA(b, h) (((b) * 2 + (h)) * HTB)
#define PG8_SB(b, h) ((4 + (b) * 2 + (h)) * HTB)
#define PG8_STAGE(bufoff, gbase, voff) do { _Pragma("unroll") for (int _i = 0; _i < 2; ++_i) \
        __builtin_amdgcn_global_load_lds((const unsigned*)((const char*)(gbase) + (voff)[_i]), (PG8_LAS unsigned*)(lds + (bufoff) + ldsw + _i * 8192), 16, 0, 0); } while (0)
#define PG8_LDA(dst, b, h) do { _Pragma("unroll") for (int m = 0; m < 4; ++m) _Pragma("unroll") for (int k = 0; k < 2; ++k) dst[m][k] = *(const PG8_LAS bf16x8*)(lds + PG8_SA(b, h) + aoff + m * 2048 + k * 1024); } while (0)
#define PG8_LDB(dst, b, h) do { _Pragma("unroll") for (int n = 0; n < 2; ++n) _Pragma("unroll") for (int k = 0; k < 2; ++k) dst[n][k] = *(const PG8_LAS bf16x8*)(lds + PG8_SB(b, h) + boff + n * 2048 + k * 1024); } while (0)
#define PG8_MMA(ai, bj, At, Bt) do { __builtin_amdgcn_s_setprio(1); _Pragma("unroll") for (int m = 0; m < 4; ++m) _Pragma("unroll") for (int n = 0; n < 2; ++n) _Pragma("unroll") for (int k = 0; k < 2; ++k) \
        acc[ai][bj][m][n] = __builtin_amdgcn_mfma_f32_16x16x32_bf16(Bt[n][k], At[m][k], acc[ai][bj][m][n], 0, 0, 0); __builtin_amdgcn_s_setprio(0); } while (0)
#define PG8_WAIT_V(n) asm volatile("s_waitcnt vmcnt(" #n ")" ::: "memory")
#define PG8_WAIT_L(n) asm volatile("s_waitcnt lgkmcnt(" #n ")" ::: "memory")
#define PG8_BAR __builtin_amdgcn_s_barrier()
#define PG8_SCHED __builtin_amdgcn_sched_barrier(0)
    Unit cur, nxt; int ui = 0;
    if (!S.next(0, cur)) return;
    f32x4 acc[2][2][4][2];
#pragma unroll
    for (int a = 0; a < 2; ++a)
#pragma unroll
        for (int b = 0; b < 2; ++b)
#pragma unroll
            for (int m = 0; m < 4; ++m)
#pragma unroll
                for (int n = 0; n < 2; ++n) acc[a][b][m][n] = (f32x4){0.f, 0.f, 0.f, 0.f};
    bf16x8 At[4][2], B0[2][2], B1[2][2];
    const char* cA = (const char*)g.A + (size_t)cur.pm * tstep; const char* cB = (const char*)g.Bt + (size_t)cur.pn * tstep;
    S.a_ready(cur);
    if constexpr (SP2) {
        PG8_STAGE(PG8_SB(0, 0), cB, voffB); PG8_STAGE(PG8_SB(0, 1), cB + hstep, voffB); PG8_STAGE(PG8_SA(0, 0), cA, voffA); PG8_STAGE(PG8_SA(0, 1), cA + hstep, voffA);
        if (wr == 1) PG8_BAR;
        PG8_WAIT_V(2); PG8_BAR;
        PG8_STAGE(PG8_SB(1, 0), cB + kstep, voffB); PG8_STAGE(PG8_SA(1, 0), cA + kstep, voffA); PG8_STAGE(PG8_SB(1, 1), cB + hstep + kstep, voffB);
        PG8_WAIT_V(6); PG8_BAR;
    } else {
        PG8_STAGE(PG8_SB(0, 0), cB, voffB); PG8_STAGE(PG8_SA(0, 0), cA, voffA); PG8_STAGE(PG8_SB(0, 1), cB + hstep, voffB); PG8_STAGE(PG8_SA(0, 1), cA + hstep, voffA);
        if (wr == 1) PG8_BAR;
        PG8_WAIT_V(4); PG8_BAR;
        PG8_STAGE(PG8_SB(1, 0), cB + kstep, voffB); PG8_STAGE(PG8_SA(1, 0), cA + kstep, voffA); PG8_STAGE(PG8_SB(1, 1), cB + hstep + kstep, voffB);
        PG8_WAIT_V(6); PG8_BAR;
    }
    for (;;) {
        const bool has_next = S.next(ui + 1, nxt);
        const char* nA = has_next ? (const char*)g.A + (size_t)nxt.pm * tstep : cA; const char* nB = has_next ? (const char*)g.Bt + (size_t)nxt.pn * tstep : cB;
        for (int t = 0; t < nt; t += 2) {
            const bool last = (t == nt - 2);
            const char* a1 = cA + (size_t)(t + 1) * kstep;
            const char* a2 = last ? nA : cA + (size_t)(t + 2) * kstep; const char* b2 = last ? nB : cB + (size_t)(t + 2) * kstep;
            const char* a3 = a2 + kstep; const char* b3 = b2 + kstep;
            if (last && has_next) S.a_ready(nxt);
            if constexpr (SP2) {
            PG8_LDB(B0, 0, 0); PG8_LDB(B1, 0, 1); PG8_SCHED; PG8_LDA(At, 0, 0); PG8_STAGE(PG8_SA(1, 1), a1 + hstep, voffA);
            PG8_WAIT_V(8); PG8_WAIT_L(0); PG8_BAR; PG8_MMA(0, 0, At, B0); PG8_MMA(0, 1, At, B1); PG8_BAR; PG8_SCHED;
            PG8_LDA(At, 0, 1); PG8_STAGE(PG8_SB(0, 0), b2, voffB); PG8_STAGE(PG8_SB(0, 1), b2 + hstep, voffB); PG8_STAGE(PG8_SA(0, 0), a2, voffA);
            PG8_WAIT_V(8); PG8_WAIT_L(0); PG8_BAR; PG8_MMA(1, 0, At, B0); PG8_MMA(1, 1, At, B1); PG8_BAR; PG8_SCHED;
            PG8_LDB(B0, 1, 0); PG8_LDB(B1, 1, 1); PG8_SCHED; PG8_LDA(At, 1, 0); PG8_STAGE(PG8_SA(0, 1), a2 + hstep, voffA);
            PG8_WAIT_V(8); PG8_WAIT_L(0); PG8_BAR; PG8_MMA(0, 0, At, B0); PG8_MMA(0, 1, At, B1); PG8_BAR; PG8_SCHED;
            PG8_LDA(At, 1, 1); PG8_STAGE(PG8_SB(1, 0), b3, voffB); PG8_STAGE(PG8_SB(1, 1), b3 + hstep, voffB); PG8_STAGE(PG8_SA(1, 0), a3, voffA);
            PG8_WAIT_V(8); PG8_WAIT_L(0); PG8_BAR; PG8_MMA(1, 0, At, B0); PG8_MMA(1, 1, At, B1); PG8_BAR; PG8_SCHED;
            } else {
            PG8_LDB(B0, 0, 0); PG8_SCHED; PG8_LDA(At, 0, 0); PG8_STAGE(PG8_SA(1, 1), a1 + hstep, voffA);
            PG8_WAIT_L(8); PG8_BAR; PG8_WAIT_L(0); PG8_MMA(0, 0, At, B0); PG8_BAR; PG8_SCHED;
            PG8_LDB(B1, 0, 1); PG8_STAGE(PG8_SB(0, 0), b2, voffB);
            PG8_BAR; PG8_WAIT_L(0); PG8_MMA(0, 1, At, B1); PG8_BAR;
            PG8_LDA(At, 0, 1); PG8_STAGE(PG8_SA(0, 0), a2, voffA);
            PG8_BAR; PG8_WAIT_L(0); PG8_MMA(1, 0, At, B0); PG8_BAR; PG8_SCHED;
            PG8_STAGE(PG8_SB(0, 1), b2 + hstep, voffB);
            PG8_WAIT_V(6); PG8_BAR; PG8_MMA(1, 1, At, B1); PG8_BAR;
            PG8_LDB(B0, 1, 0); PG8_SCHED; PG8_LDA(At, 1, 0); PG8_STAGE(PG8_SA(0, 1), a2 + hstep, voffA);
            PG8_WAIT_L(8); PG8_BAR; PG8_WAIT_L(0); PG8_MMA(0, 0, At, B0); PG8_BAR; PG8_SCHED;
            PG8_LDB(B1, 1, 1); PG8_STAGE(PG8_SB(1, 0), b3, voffB);
            PG8_BAR; PG8_WAIT_L(0); PG8_MMA(0, 1, At, B1); PG8_BAR;
            PG8_LDA(At, 1, 1); PG8_STAGE(PG8_SA(1, 0), a3, voffA);
            PG8_BAR; PG8_WAIT_L(0); PG8_MMA(1, 0, At, B0); PG8_BAR; PG8_SCHED;
            PG8_STAGE(PG8_SB(1, 1), b3 + hstep, voffB);
            PG8_WAIT_V(6); PG8_BAR; PG8_MMA(1, 1, At, B1); PG8_BAR;
            }
        }
        if constexpr (ALIGN_EPI) { if (wr == 0) PG8_BAR; }
        if constexpr (!Epi::AFTER_DRAIN) { E(acc, cur, wr, wc, fr, fq); S.done(cur); }
        if (!has_next) break;
#pragma unroll
        for (int a = 0; a < 2; ++a)
#pragma unroll
            for (int b = 0; b < 2; ++b)
#pragma unroll
                for (int m = 0; m < 4; ++m)
#pragma unroll
                    for (int n = 0; n < 2; ++n) acc[a][b][m][n] = (f32x4){0.f, 0.f, 0.f, 0.f};
        cur = nxt; cA = nA; cB = nB; ++ui;
        if constexpr (ALIGN_EPI) { if (wr == 1) PG8_BAR; }
    }
    PG8_WAIT_V(0);
    if constexpr (!ALIGN_EPI) { if (wr == 0) PG8_BAR; }
    PG8_BAR;
    if constexpr (Epi::AFTER_DRAIN) { E.fused(acc, cur, wr, wc, fr, fq, lds, wid, lane); S.done(cur); }
#undef PG8_SA
#undef PG8_SB
#undef PG8_STAGE
#undef PG8_LDA
#undef PG8_LDB
#undef PG8_MMA
#undef PG8_WAIT_V
#undef PG8_WAIT_L
#undef PG8_BAR
#undef PG8_SCHED
}
}

#define DI __device__ __forceinline__
#define LAS __attribute__((address_space(3)))
using pg8::f32x4; using pg8::bf16_t; using pg8::bf16x8; using pg8::Unit;
typedef unsigned u32x2 __attribute__((ext_vector_type(2)));
typedef unsigned u32x4 __attribute__((ext_vector_type(4)));
typedef short s16x4 __attribute__((ext_vector_type(4)));
typedef float f32x16 __attribute__((ext_vector_type(16)));
typedef float f32x2_t __attribute__((ext_vector_type(2)));
typedef __bf16 bf16x2_t __attribute__((ext_vector_type(2)));
typedef LAS unsigned char* ldsp;

constexpr int MTOK = 16384, DM = 1024, SEQ = 8192, FF = 4096;
constexpr int WIN_COLS = 1952, WIN_PAD = 2048;
constexpr float EPS = 1e-6f;
constexpr float LOG2E = 1.4426950408889634f;
constexpr float QS_D = 0.125f * LOG2E;
constexpr float QS_M = 0.10206207261596575f * LOG2E;
#ifndef PH_MASK
#define PH_MASK 0xFFFF
#endif
constexpr int NTHREADS = 512;
constexpr int LDS_BYTES = 131072 + 2048;

constexpr size_t MiB = 1u << 20;
constexpr size_t WS_BAR = 1u << 20, WS_BAR_BYTES = 16384;
constexpr size_t WS_REFS = 240 * 1024;
constexpr size_t WS_MOD = 0, WS_BIAS1 = 98304, WS_BIAS2 = 131072, WS_GS1 = 196608, WS_GS2 = 212992;
constexpr size_t WS_W = 2 * MiB, WS_WSTRIDE = 23 * MiB;
constexpr size_t WO_IN = 0, WO_QU = 4 * MiB, WO_KV = 4 * MiB + 512 * 1024, WO_OUT = 5 * MiB, WO_W1 = 7 * MiB, WO_W2 = 15 * MiB;
constexpr size_t WS_XA = 48 * MiB;
constexpr size_t WS_QD = 80 * MiB, WS_KD = 96 * MiB, WS_VD = 112 * MiB, WS_QM = 128 * MiB, WS_KN = 152 * MiB, WS_VM = 168 * MiB, WS_OC = 184 * MiB;
constexpr size_t WS_KR = 216 * MiB, WS_CQ = 217 * MiB, WS_CKV = 225 * MiB, WS_PART = 217 * MiB, WS_LP = 249 * MiB;
constexpr size_t WS_SSQX = 250 * MiB, WS_SSQ2 = 251 * MiB, WS_SSQCQ = 252 * MiB, WS_SSQCKV = 252 * MiB + 256 * 1024;
constexpr size_t WS_H = 80 * MiB;
constexpr size_t WS_RCOS = 253 * MiB, WS_RSIN = 254 * MiB;
constexpr size_t WS_END = 255 * MiB;

__constant__ float c_inv[16] = {1.000000000e+00f, 5.623413324e-01f, 3.162277639e-01f, 1.778279394e-01f, 1.000000015e-01f, 5.623413250e-02f, 3.162277490e-02f, 1.778279431e-02f,
                                9.999999776e-03f, 5.623413250e-03f, 3.162277630e-03f, 1.778279431e-03f, 1.000000047e-03f, 5.623413017e-04f, 3.162277571e-04f, 1.778279402e-04f};

struct Params {
    const float* x; const float* c; const int* pos; const float* w_mod; const float* b_mod; const float* g_norm_mix; const float* w_in;
    const float* g_q_dil; const float* g_k_dil; const float* g_cq; const float* w_q_up; const float* g_ckv; const float* w_kv_up;
    const float* g_q_nope; const float* g_q_rope; const float* g_k_nope; const float* g_k_rope; const float* w_out; const float* g_norm_mlp;
    const float* w_mlp_in; const float* w_mlp_out; float* out; unsigned char* ws;
};

typedef __attribute__((address_space(4))) const char* c4ptr_t; typedef __attribute__((address_space(4))) const unsigned long long* c4u64_t;
#define GASP __attribute__((address_space(1)))
DI unsigned long long karg_u64(int off) { c4ptr_t kp = (c4ptr_t)__builtin_amdgcn_kernarg_segment_ptr(); asm volatile("" : "+s"(kp)); return *(c4u64_t)(kp + off); }
template <class T> DI T* gptr(unsigned long long v) { return (T*)(GASP T*)v; }
template <class P> struct pointee_of; template <class T> struct pointee_of<T*> { typedef T type; };
#define PF(name) (gptr<pointee_of<decltype(Params::name)>::type>(karg_u64((int)__builtin_offsetof(Params, name))))
DI int lane_id_v() { int l; asm volatile("v_mbcnt_lo_u32_b32 %0, -1, 0\n\tv_mbcnt_hi_u32_b32 %0, -1, %0" : "=v"(l)); return l; }
DI unsigned pk2(float lo, float hi) { f32x2_t v = {lo, hi}; bf16x2_t b = __builtin_convertvector(v, bf16x2_t); return __builtin_bit_cast(unsigned, b); }
DI u32x2 pack4(f32x4 v) { u32x2 w; w.x = pk2(v[0], v[1]); w.y = pk2(v[2], v[3]); return w; }
DI float sum4(f32x4 v) { return (v[0] + v[1]) + (v[2] + v[3]); }
DI float sq4(f32x4 v) { return (v[0] * v[0] + v[1] * v[1]) + (v[2] * v[2] + v[3] * v[3]); }
DI float xor16_sum(float v) { auto r = __builtin_amdgcn_permlane16_swap(__float_as_uint(v), __float_as_uint(v), false, false); return __uint_as_float(r[0]) + __uint_as_float(r[1]); }
DI float xor32_sum(float v) { auto r = __builtin_amdgcn_permlane32_swap(__float_as_uint(v), __float_as_uint(v), false, false); return __uint_as_float(r[0]) + __uint_as_float(r[1]); }
template <int K> DI float swz_xor(float v) { return __uint_as_float((unsigned)__builtin_amdgcn_ds_swizzle((int)__float_as_uint(v), (K << 10) | 0x1f)); }
DI float red_fq(float s) { return xor32_sum(xor16_sum(s)); }
DI float wave_sum(float v) { v += swz_xor<1>(v); v += swz_xor<2>(v); v += swz_xor<4>(v); v += swz_xor<8>(v); return xor32_sum(xor16_sum(v)); }
DI float umax_abs(const float* g, int n) { float r = 0.f; for (int i = 0; i < n; ++i) r = fmaxf(r, fabsf(g[i])); return r; }
DI float fadd_s(float a, float b) { float r; asm("v_add_f32_e32 %0, %1, %2" : "=v"(r) : "v"(a), "v"(b)); return r; }
DI float rsq(float v) { return __builtin_amdgcn_rsqf(v); }
DI float bf2f(unsigned short u) { return __uint_as_float(((unsigned)u) << 16); }
DI void sincos_rev(float ang, float& s, float& c) {
    const double rev = (double)ang * 0.15915494309189535;
    const float f = (float)(rev - __builtin_rint(rev));
    s = __builtin_amdgcn_sinf(f); c = __builtin_amdgcn_cosf(f);
}

#define GAS __attribute__((address_space(1)))
#define XB_TMO      128
#define XB_XCNT(j)  (256  + 64 * (j))
#define XB_XSUB(j)  (1280 + 64 * (j))
#define XB_XGEN(j)  (2304 + 64 * (j))
#define XB_TOP      3328
#define XB_TOPGEN   3392
#define XCD_BAR_WORDS 3456
#define XB_SPIN_CAP (1u << 18)

__device__ __forceinline__ unsigned xb_ld(unsigned* p)              { return __hip_atomic_load(p, __ATOMIC_RELAXED, __HIP_MEMORY_SCOPE_AGENT); }
__device__ __forceinline__ unsigned xb_add(unsigned* p, unsigned v) { return __hip_atomic_fetch_add(p, v, __ATOMIC_RELAXED, __HIP_MEMORY_SCOPE_AGENT); }
__device__ __forceinline__ unsigned xb_xcc_id() { return (unsigned)__builtin_amdgcn_s_getreg((3 << 11) | 20) & 0xFu; }
#define XB_SPIN(cond, bar) do { unsigned _sp = 0; while (cond) { __builtin_amdgcn_s_sleep(1); \
    if ((++_sp & 255u) == 0u) { if (xb_ld(&(bar)[XB_TMO])) break; if (_sp > XB_SPIN_CAP) { atomicAdd(&(bar)[XB_TMO], 1u); break; } } } } while (0)

struct XcdBarrier {
    unsigned* bar; unsigned x;
    volatile LAS unsigned* st;
};

__device__ __forceinline__ XcdBarrier xcd_barrier_post(unsigned* bar, volatile LAS unsigned* st, const int tid) {
    XcdBarrier b; b.bar = bar; b.x = xb_xcc_id(); b.st = st;
    if (tid == 0) (void)xb_add(&bar[XB_XCNT(b.x)], 1u);
    return b;
}
__device__ __forceinline__ void xcd_barrier_complete(unsigned* bar, unsigned x, unsigned& nloc, unsigned& nx) {
    const unsigned G = gridDim.x * gridDim.y * gridDim.z;
    unsigned sum, cnt, mine, sp = 0u;
    for (;;) {
        sum = 0u; cnt = 0u; mine = 0u;
#pragma unroll
        for (unsigned j = 0; j < 16; ++j) { const unsigned c = xb_ld(&bar[XB_XCNT(j)]); sum += c; cnt += (c > 0u) ? 1u : 0u; mine = (j == x) ? c : mine; }
        if (sum == G) break;
        __builtin_amdgcn_s_sleep(1);
        if ((++sp & 255u) == 0u) { if (xb_ld(&bar[XB_TMO])) break; if (sp > XB_SPIN_CAP) { atomicAdd(&bar[XB_TMO], 1u); break; } }
    }
    nloc = mine > 0u ? mine : 1u; nx = cnt > 0u ? cnt : 1u;
}

__device__ __forceinline__ void xcd_barrier(const XcdBarrier& b, const int tid) {
    asm volatile("s_waitcnt vmcnt(0)" ::: "memory");
    __syncthreads();
    if (tid == 0) {
        unsigned* bar = b.bar;
        __builtin_amdgcn_s_waitcnt(0);
        unsigned nloc = b.st[0], nx = b.st[1];
        if (nloc == 0u) { xcd_barrier_complete(bar, b.x, nloc, nx); b.st[0] = nloc; b.st[1] = nx; }
        const unsigned old = xb_add(&bar[XB_XSUB(b.x)], 1u);
        const unsigned gen = old / nloc;
        if (old + 1u == (gen + 1u) * nloc) {
            __builtin_amdgcn_fence(__ATOMIC_RELEASE, "agent");
            asm volatile("s_waitcnt vmcnt(0)" ::: "memory");
            const unsigned og = xb_add(&bar[XB_TOP], 1u);
            const unsigned tg = og / nx;
            if (og + 1u == (tg + 1u) * nx) xb_add(&bar[XB_TOPGEN], 1u);
            else XB_SPIN(xb_ld(&bar[XB_TOPGEN]) == tg, bar);
            __builtin_amdgcn_fence(__ATOMIC_ACQUIRE, "agent");
            xb_add(&bar[XB_XGEN(b.x)], 1u);
            asm volatile("s_waitcnt vmcnt(0)" ::: "memory");
        } else {
            XB_SPIN(xb_ld(&bar[XB_XGEN(b.x)]) == gen, bar);
            __builtin_amdgcn_fence(__ATOMIC_ACQUIRE, "agent");
            asm volatile("s_waitcnt vmcnt(0)" ::: "memory");
        }
    }
    __syncthreads();
}


#define EPI_FENCE() asm volatile("" ::: "memory")
struct EpiIn {
    static constexpr bool PERM = true, AFTER_DRAIN = false;
    unsigned char* wsb; const float* bias; const float* gq; const float* gk; const float* gkr;
    DI void operator()(const f32x4 (&acc)[2][2][4][2], const Unit& u, int wr, int wc, int fr, int fq) const {
        const float* ssq = (const float*)(wsb + WS_SSQX); const float* rcos = (const float*)(wsb + WS_RCOS); const float* rsin = (const float*)(wsb + WS_RSIN);
        bf16_t* Qd = (bf16_t*)(wsb + WS_QD); bf16_t* Kd = (bf16_t*)(wsb + WS_KD); bf16_t* Vd = (bf16_t*)(wsb + WS_VD);
        bf16_t* CQ = (bf16_t*)(wsb + WS_CQ); bf16_t* CKV = (bf16_t*)(wsb + WS_CKV); bf16_t* Kr = (bf16_t*)(wsb + WS_KR);
        float* ssq_cq = (float*)(wsb + WS_SSQCQ); float* ssq_ckv = (float*)(wsb + WS_SSQCKV);
        const int b = u.pm >> 5, pn = u.pn, lc0 = 64 * wc + 8 * fq;
        const float* bp = bias + b * WIN_PAD + 256 * pn + lc0;
        f32x4 bv[2][2], gv[2][2];
#pragma unroll
        for (int bj = 0; bj < 2; ++bj)
#pragma unroll
            for (int n = 0; n < 2; ++n) { bv[bj][n] = *(const f32x4*)(bp + 32 * bj + 4 * n); gv[bj][n] = (f32x4){1.f, 1.f, 1.f, 1.f}; }
        if (pn < 4) { const float* g = (pn < 2 ? gq : gk) + 8 * fq;
#pragma unroll
            for (int bj = 0; bj < 2; ++bj)
#pragma unroll
                for (int n = 0; n < 2; ++n) gv[bj][n] = *(const f32x4*)(g + 32 * bj + 4 * n);
        } else if (pn == 7) { gv[0][0] = *(const f32x4*)(gkr + 8 * fq); gv[0][1] = *(const f32x4*)(gkr + 8 * fq + 4); }
        float rstdv[2][4];
#pragma unroll
        for (int ai = 0; ai < 2; ++ai)
#pragma unroll
            for (int m = 0; m < 4; ++m) { const int row = u.pm * 256 + ai * 128 + wr * 64 + m * 16 + fr;
                rstdv[ai][m] = rsq(red_fq(sum4(*(const f32x4*)(ssq + (size_t)row * 16 + 4 * fq))) * (1.f / 1024.f) + EPS); }
#define EPI_ST16(dst_, v0_, v1_) do { u32x4 w_; w_.x = pk2((v0_)[0], (v0_)[1]); w_.y = pk2((v0_)[2], (v0_)[3]); w_.z = pk2((v1_)[0], (v1_)[1]); w_.w = pk2((v1_)[2], (v1_)[3]); *(u32x4*)(dst_) = w_; } while (0)
#pragma unroll
        for (int ai = 0; ai < 2; ++ai)
#pragma unroll
            for (int m = 0; m < 4; ++m) {
                const int row = u.pm * 256 + ai * 128 + wr * 64 + m * 16 + fr;
                const float rstd = rstdv[ai][m];
                f32x4 z[2][2]; float ss = 0.f;
#pragma unroll
                for (int bj = 0; bj < 2; ++bj)
#pragma unroll
                    for (int n = 0; n < 2; ++n) { z[bj][n] = acc[ai][bj][m][n] * rstd + bv[bj][n]; ss += sq4(z[bj][n]); }
                if (pn < 4) {
                    ss = red_fq(ss);
                    const float r = rsq(ss * (1.f / 64.f) + EPS) * (pn < 2 ? QS_D : 1.f);
                    bf16_t* dst = (pn < 2 ? Qd : Kd) + (size_t)row * 512 + (pn & 1) * 256 + lc0;
#pragma unroll
                    for (int bj = 0; bj < 2; ++bj) EPI_ST16(dst + 32 * bj, z[bj][0] * r * gv[bj][0], z[bj][1] * r * gv[bj][1]);
                } else if (pn < 6) {
                    bf16_t* dst = Vd + (size_t)row * 512 + (pn - 4) * 256 + lc0;
#pragma unroll
                    for (int bj = 0; bj < 2; ++bj) EPI_ST16(dst + 32 * bj, z[bj][0], z[bj][1]);
                } else if (pn == 6) {
                    ss = red_fq(ss);
                    bf16_t* dst = CQ + (size_t)row * 256 + lc0;
#pragma unroll
                    for (int bj = 0; bj < 2; ++bj) EPI_ST16(dst + 32 * bj, z[bj][0], z[bj][1]);
                    if (fq == 0) ssq_cq[(size_t)row * 4 + wc] = ss;
                } else {
                    if (wc < 2) {
                        ss = red_fq(ss);
                        bf16_t* dst = CKV + (size_t)row * 128 + lc0;
#pragma unroll
                        for (int bj = 0; bj < 2; ++bj) EPI_ST16(dst + 32 * bj, z[bj][0], z[bj][1]);
                        if (fq == 0) ssq_ckv[(size_t)row * 2 + wc] = ss;
                    } else if (wc == 2) {
                        const float s8 = red_fq(sq4(z[0][0]) + sq4(z[0][1]));
                        const float r = rsq(s8 * (1.f / 32.f) + EPS);
                        const float sg = fq < 2 ? -1.f : 1.f;
                        f32x4 o0, o1;
#pragma unroll
                        for (int n = 0; n < 2; ++n) {
                            const f32x4 y = z[0][n] * r * gv[0][n];
                            const f32x4 cv = *(const f32x4*)(rcos + (size_t)row * 16 + 8 * (fq & 1) + 4 * n), sv = *(const f32x4*)(rsin + (size_t)row * 16 + 8 * (fq & 1) + 4 * n);
                            f32x4 o;
#pragma unroll
                            for (int e = 0; e < 4; ++e) {
                                auto sw = __builtin_amdgcn_permlane32_swap(__float_as_uint(y[e]), __float_as_uint(y[e]), false, false);
                                const float p = __uint_as_float(fq < 2 ? sw[1] : sw[0]);
                                o[e] = y[e] * cv[e] + p * sv[e] * sg; }
                            if (n == 0) o0 = o; else o1 = o;
                        }
                        EPI_ST16(Kr + (size_t)row * 32 + 8 * fq, o0, o1);
                    }
                }
                EPI_FENCE();
            }
#undef EPI_ST16
    }
};

struct EpiQup {
    static constexpr bool PERM = true, AFTER_DRAIN = false;
    const float* ssq_cq; const float* gqn; const float* gqr; const float* rcos; const float* rsin; bf16_t* Qm;
    DI void operator()(const f32x4 (&acc)[2][2][4][2], const Unit& u, int wr, int wc, int fr, int fq) const {
        const int pn = u.pn;
        float rstdv[2][4];
#pragma unroll
        for (int ai = 0; ai < 2; ++ai)
#pragma unroll
            for (int m = 0; m < 4; ++m) { const int row = u.pm * 256 + ai * 128 + wr * 64 + m * 16 + fr;
                rstdv[ai][m] = rsq(sum4(*(const f32x4*)(ssq_cq + (size_t)row * 4)) * (1.f / 256.f) + EPS); }
#pragma unroll
        for (int ai = 0; ai < 2; ++ai)
#pragma unroll
            for (int m = 0; m < 4; ++m) {
                const int row = u.pm * 256 + ai * 128 + wr * 64 + m * 16 + fr;
                const float rstd = rstdv[ai][m];
                f32x4 z[2][2];
#pragma unroll
                for (int bj = 0; bj < 2; ++bj)
#pragma unroll
                    for (int n = 0; n < 2; ++n) z[bj][n] = acc[ai][bj][m][n] * rstd;
                if (pn < 2) {
                    float ss = (sq4(z[0][0]) + sq4(z[0][1])) + (sq4(z[1][0]) + sq4(z[1][1]));
                    ss = red_fq(ss);
                    const float r = rsq(ss * (1.f / 64.f) + EPS) * QS_M;
                    bf16_t* dst = Qm + (size_t)row * 768 + (4 * pn + wc) * 96 + 8 * fq;
#pragma unroll
                    for (int bj = 0; bj < 2; ++bj) { const f32x4 y0 = z[bj][0] * r * *(const f32x4*)(gqn + 8 * fq + 32 * bj), y1 = z[bj][1] * r * *(const f32x4*)(gqn + 8 * fq + 32 * bj + 4);
                        u32x4 w; w.x = pk2(y0[0], y0[1]); w.y = pk2(y0[2], y0[3]); w.z = pk2(y1[0], y1[1]); w.w = pk2(y1[2], y1[3]); *(u32x4*)(dst + 32 * bj) = w; }
                } else {
                    const float sg = fq < 2 ? -1.f : 1.f;
#pragma unroll
                    for (int bj = 0; bj < 2; ++bj) {
                        const float s8 = red_fq(sq4(z[bj][0]) + sq4(z[bj][1]));
                        const float r = rsq(s8 * (1.f / 32.f) + EPS) * QS_M;
                        f32x4 o0, o1;
#pragma unroll
                        for (int n = 0; n < 2; ++n) {
                            const f32x4 y = z[bj][n] * r * *(const f32x4*)(gqr + 8 * fq + 4 * n);
                            const f32x4 cv = *(const f32x4*)(rcos + (size_t)row * 16 + 8 * (fq & 1) + 4 * n), sv = *(const f32x4*)(rsin + (size_t)row * 16 + 8 * (fq & 1) + 4 * n);
                            f32x4 o;
#pragma unroll
                            for (int e = 0; e < 4; ++e) {
                                auto sw = __builtin_amdgcn_permlane32_swap(__float_as_uint(y[e]), __float_as_uint(y[e]), false, false);
                                const float p = __uint_as_float(fq < 2 ? sw[1] : sw[0]);
                                o[e] = y[e] * cv[e] + p * sv[e] * sg; }
                            if (n == 0) o0 = o; else o1 = o;
                        }
                        bf16_t* dst = Qm + (size_t)row * 768 + (2 * wc + bj) * 96 + 64 + 8 * fq;
                        u32x4 w; w.x = pk2(o0[0], o0[1]); w.y = pk2(o0[2], o0[3]); w.z = pk2(o1[0], o1[1]); w.w = pk2(o1[2], o1[3]); *(u32x4*)dst = w;
                    }
                }
            }
    }
};

struct EpiKvup {
    static constexpr bool PERM = true, AFTER_DRAIN = false;
    const float* ssq_ckv; const float* gkn; bf16_t* Kn; bf16_t* Vm;
    DI void operator()(const f32x4 (&acc)[2][2][4][2], const Unit& u, int wr, int wc, int fr, int fq) const {
        const int pn = u.pn;
        float rstdv[2][4];
#pragma unroll
        for (int ai = 0; ai < 2; ++ai)
#pragma unroll
            for (int m = 0; m < 4; ++m) { const int row = u.pm * 256 + ai * 128 + wr * 64 + m * 16 + fr;
                const f32x2_t sp = *(const f32x2_t*)(ssq_ckv + (size_t)row * 2); rstdv[ai][m] = rsq((sp[0] + sp[1]) * (1.f / 128.f) + EPS); }
#pragma unroll
        for (int ai = 0; ai < 2; ++ai)
#pragma unroll
            for (int m = 0; m < 4; ++m) {
                const int row = u.pm * 256 + ai * 128 + wr * 64 + m * 16 + fr;
                const float rstd = rstdv[ai][m];
                f32x4 z[2][2];
#pragma unroll
                for (int bj = 0; bj < 2; ++bj)
#pragma unroll
                    for (int n = 0; n < 2; ++n) z[bj][n] = acc[ai][bj][m][n] * rstd;
                if (pn < 2) {
                    float ss = (sq4(z[0][0]) + sq4(z[0][1])) + (sq4(z[1][0]) + sq4(z[1][1]));
                    ss = red_fq(ss);
                    const float r = rsq(ss * (1.f / 64.f) + EPS);
                    bf16_t* dst = Kn + (size_t)row * 512 + (4 * pn + wc) * 64 + 8 * fq;
#pragma unroll
                    for (int bj = 0; bj < 2; ++bj) { const f32x4 y0 = z[bj][0] * r * *(const f32x4*)(gkn + 8 * fq + 32 * bj), y1 = z[bj][1] * r * *(const f32x4*)(gkn + 8 * fq + 32 * bj + 4);
                        u32x4 w; w.x = pk2(y0[0], y0[1]); w.y = pk2(y0[2], y0[3]); w.z = pk2(y1[0], y1[1]); w.w = pk2(y1[2], y1[3]); *(u32x4*)(dst + 32 * bj) = w; }
                } else {
                    bf16_t* dst = Vm + (size_t)row * 512 + (4 * (pn - 2) + wc) * 64 + 8 * fq;
#pragma unroll
                    for (int bj = 0; bj < 2; ++bj) { u32x4 w; w.x = pk2(z[bj][0][0], z[bj][0][1]); w.y = pk2(z[bj][0][2], z[bj][0][3]); w.z = pk2(z[bj][1][0], z[bj][1][1]); w.w = pk2(z[bj][1][2], z[bj][1][3]);
                        *(u32x4*)(dst + 32 * bj) = w; }
                }
            }
    }
};

struct EpiRes {
    static constexpr bool PERM = true, AFTER_DRAIN = false;
    const float* xin; float* out; const float* gate; const float* gs; bf16_t* XA; float* ssq;
    DI void operator()(const f32x4 (&acc)[2][2][4][2], const Unit& u, int wr, int wc, int fr, int fq) const {
        const int b = u.pm >> 5, c0 = u.pn * 256 + wc * 32 + 8 * fq;
        f32x4 gt[2][2], gsv[2][2];
#pragma unroll
        for (int bj = 0; bj < 2; ++bj)
#pragma unroll
            for (int n = 0; n < 2; ++n) { gt[bj][n] = *(const f32x4*)(gate + b * 6144 + c0 + 128 * bj + 4 * n);
                gsv[bj][n] = gs ? *(const f32x4*)(gs + b * DM + c0 + 128 * bj + 4 * n) : (f32x4){0.f, 0.f, 0.f, 0.f}; }
        f32x4 xc[2][2], xn[2][2];
#pragma unroll
        for (int bj = 0; bj < 2; ++bj)
#pragma unroll
            for (int n = 0; n < 2; ++n) xc[bj][n] = *(const f32x4*)(xin + (size_t)(u.pm * 256 + wr * 64 + fr) * DM + c0 + 128 * bj + 4 * n);
#pragma unroll
        for (int rg = 0; rg < 8; ++rg) {
            const int ai = rg >> 2, m = rg & 3;
            const int row = u.pm * 256 + ai * 128 + wr * 64 + m * 16 + fr;
            const size_t off = (size_t)row * DM + c0;
            if (rg < 7) { const int ai2 = (rg + 1) >> 2, m2 = (rg + 1) & 3; const size_t off2 = (size_t)(u.pm * 256 + ai2 * 128 + wr * 64 + m2 * 16 + fr) * DM + c0;
#pragma unroll
                for (int bj = 0; bj < 2; ++bj)
#pragma unroll
                    for (int n = 0; n < 2; ++n) xn[bj][n] = *(const f32x4*)(xin + off2 + 128 * bj + 4 * n); }
            float ss = 0.f;
#pragma unroll
            for (int bj = 0; bj < 2; ++bj) {
                const f32x4 xo0 = xc[bj][0] + gt[bj][0] * acc[ai][bj][m][0], xo1 = xc[bj][1] + gt[bj][1] * acc[ai][bj][m][1];
                *(f32x4*)(out + off + 128 * bj) = xo0; *(f32x4*)(out + off + 128 * bj + 4) = xo1;
                if (gs) { ss += sq4(xo0) + sq4(xo1); const f32x4 y0 = xo0 * gsv[bj][0], y1 = xo1 * gsv[bj][1];
                    u32x4 w; w.x = pk2(y0[0], y0[1]); w.y = pk2(y0[2], y0[3]); w.z = pk2(y1[0], y1[1]); w.w = pk2(y1[2], y1[3]);
                    *(u32x4*)(XA + off + 128 * bj) = w; }
            }
            if (gs) { ss = red_fq(ss); if (fq == 0) ssq[(size_t)row * 16 + 4 * u.pn + wc] = ss; }
#pragma unroll
            for (int bj = 0; bj < 2; ++bj)
#pragma unroll
                for (int n = 0; n < 2; ++n) xc[bj][n] = xn[bj][n];
        }
    }
};

struct EpiUp {
    static constexpr bool PERM = true, AFTER_DRAIN = false;
    const float* ssq; const float* bias; bf16_t* H;
    DI void operator()(const f32x4 (&acc)[2][2][4][2], const Unit& u, int wr, int wc, int fr, int fq) const {
        const int b = u.pm >> 5, c0 = u.pn * 256 + wc * 32 + 8 * fq;
        f32x4 bv[2][2];
#pragma unroll
        for (int bj = 0; bj < 2; ++bj)
#pragma unroll
            for (int n = 0; n < 2; ++n) bv[bj][n] = *(const f32x4*)(bias + b * FF + c0 + 128 * bj + 4 * n);
        float rstdv[2][4];
#pragma unroll
        for (int ai = 0; ai < 2; ++ai)
#pragma unroll
            for (int m = 0; m < 4; ++m) { const int row = u.pm * 256 + ai * 128 + wr * 64 + m * 16 + fr;
                rstdv[ai][m] = rsq(red_fq(sum4(*(const f32x4*)(ssq + (size_t)row * 16 + 4 * fq))) * (1.f / 1024.f) + EPS); }
#pragma unroll
        for (int ai = 0; ai < 2; ++ai)
#pragma unroll
            for (int m = 0; m < 4; ++m) {
                const int row = u.pm * 256 + ai * 128 + wr * 64 + m * 16 + fr;
                const float rstd = rstdv[ai][m];
                bf16_t* dst = H + (size_t)row * FF + c0;
#pragma unroll
                for (int bj = 0; bj < 2; ++bj) {
                    f32x4 z0 = acc[ai][bj][m][0] * rstd + bv[bj][0], z1 = acc[ai][bj][m][1] * rstd + bv[bj][1];
#pragma unroll
                    for (int e = 0; e < 4; ++e) { const float t0 = fmaxf(z0[e], 0.f), t1 = fmaxf(z1[e], 0.f); z0[e] = t0 * t0; z1[e] = t1 * t1; }
                    u32x4 w; w.x = pk2(z0[0], z0[1]); w.y = pk2(z0[2], z0[3]); w.z = pk2(z1[0], z1[1]); w.w = pk2(z1[2], z1[3]);
                    *(u32x4*)(dst + 128 * bj) = w;
                }
            }
    }
};

template <class LB>
DI void transpose_item(const float* W, int K, int N, int NpG  , bf16_t* WT, const float* gk, LAS float* scr, int item, int lane, LB lbase) {
    const int kb = item / NpG, G = item % NpG, k0 = 64 * kb;
    const int lb = lbase(G);
#pragma unroll
    for (int i = 0; i < 8; ++i) { const int kk = 8 * i + (lane >> 3), c4 = lane & 7;
        f32x4 v = (f32x4){0.f, 0.f, 0.f, 0.f};
        if (lb >= 0) { v = *(const f32x4*)(W + (size_t)(k0 + kk) * N + lb + 4 * c4); if (gk) v = v * gk[k0 + kk]; }
        LAS float* d = scr + kk * 33 + 4 * c4; d[0] = v[0]; d[1] = v[1]; d[2] = v[2]; d[3] = v[3]; }
    asm volatile("s_waitcnt lgkmcnt(0)" ::: "memory");
    const int c = lane & 7;
#pragma unroll
    for (int j = 0; j < 4; ++j) { const int n = (lane >> 3) + 8 * j; const LAS float* s = scr + (8 * c) * 33 + n;
        u32x4 o; o.x = pk2(s[0 * 33], s[1 * 33]); o.y = pk2(s[2 * 33], s[3 * 33]); o.z = pk2(s[4 * 33], s[5 * 33]); o.w = pk2(s[6 * 33], s[7 * 33]);
        *(u32x4*)(WT + (size_t)(32 * G + n) * K + k0 + 8 * c) = o; }
    asm volatile("s_waitcnt lgkmcnt(0)" ::: "memory");
}

DI void gemv_unit(const float* W, int N, int Nout, int nb, const LAS float* vecs, LAS float* red, float* out0, float* out1, const float* addend, int tid) {
    const int wid = tid >> 6, lane = tid & 63, n = nb * 64 + lane; const bool ok = n < N;
    float a0 = 0.f, a1 = 0.f;
    const float* wp = W + (size_t)(wid * 128) * N + (ok ? n : 0);
#pragma unroll 32
    for (int k = 0; k < 128; ++k) { const float w = ok ? wp[(size_t)k * N] : 0.f; a0 += vecs[wid * 128 + k] * w; a1 += vecs[1024 + wid * 128 + k] * w; }
    red[(wid * 2 + 0) * 64 + lane] = a0; red[(wid * 2 + 1) * 64 + lane] = a1;
    __syncthreads();
    if (tid < 128) { const int bb = tid >> 6, ln = tid & 63; float s = 0.f;
#pragma unroll
        for (int w = 0; w < 8; ++w) s += red[(w * 2 + bb) * 64 + ln];
        const int nn = nb * 64 + ln; if (nn < Nout) (bb ? out1 : out0)[nn] = s + ((addend && nn < N) ? addend[nn] : 0.f); }
    __syncthreads();
}

#define MFMA32(a, b, c) __builtin_amdgcn_mfma_f32_32x32x16_bf16((a), (b), (c), 0, 0, 0)
DI int crow(int r, int hi) { return (r & 3) + 8 * (r >> 2) + 4 * hi; }
DI bf16x8 pack8(const f32x16& p, int s) { u32x4 w; w.x = pk2(p[8 * s + 0], p[8 * s + 1]); w.y = pk2(p[8 * s + 2], p[8 * s + 3]); w.z = pk2(p[8 * s + 4], p[8 * s + 5]); w.w = pk2(p[8 * s + 6], p[8 * s + 7]); return __builtin_bit_cast(bf16x8, w); }
typedef short v4i16_t __attribute__((ext_vector_type(4)));
DI bf16x8 vfrag_tr(const LAS unsigned char* p, int second) { const s16x4 lo = __builtin_bit_cast(s16x4, __builtin_amdgcn_ds_read_tr16_b64_v4i16((LAS v4i16_t*)p)), hi = __builtin_bit_cast(s16x4, __builtin_amdgcn_ds_read_tr16_b64_v4i16((LAS v4i16_t*)(p + second))); return (bf16x8){lo[0], lo[1], lo[2], lo[3], hi[0], hi[1], hi[2], hi[3]}; }
DI bf16x8 vfrag(const LAS unsigned char* p) { const s16x4 lo = *(const LAS s16x4*)p, hi = *(const LAS s16x4*)(p + 16); return (bf16x8){lo[0], lo[1], lo[2], lo[3], hi[0], hi[1], hi[2], hi[3]}; }

constexpr int KSTR = 208, VSTR = 136, KBUF = 64 * KSTR, VBUF = 64 * VSTR;
#define SBAR() __builtin_amdgcn_sched_barrier(0)
DI void mla_unit(ldsp lds, int b, int h, int qb, const bf16_t* Qm_, const bf16_t* Kn_, const bf16_t* Kr_, const bf16_t* Vm_, bf16_t* OC_, float ref, const int wid) {
    int lane = lane_id_v(); asm volatile("" : "+v"(lane));
    const int tid = wid * 64 + lane, q = lane & 31, hi = lane >> 5;
    constexpr int NT = SEQ / 64;
    constexpr int VR = 192, VBUF2 = 64 * VR;
    const int rot = (qb * 4) & (NT - 1);
    const size_t tokb = (size_t)b * SEQ;
    bf16x8 qf[6];
    { const size_t tq = tokb + qb * 256 + wid * 32 + q;
#pragma unroll
    for (int d0 = 0; d0 < 6; ++d0) qf[d0] = *(const bf16x8*)(Qm_ + tq * 768 + h * 96 + d0 * 16 + hi * 8); }
    f32x16 o0, o1, negref;
#pragma unroll
    for (int r = 0; r < 16; ++r) { o0[r] = 0.f; o1[r] = 0.f; negref[r] = 0.f; }
    float lsA = 0.f, lsB = 0.f;
    const int s_row = tid >> 3, s_part = tid & 7, r_row = (tid >> 2) & 63, r_part = tid & 3;
    const char* kn_base = (const char*)(Kn_ + tokb * 512 + h * 64);
    const char* kr_base = (const char*)(Kr_ + tokb * 32);
    const char* v_base = (const char*)(Vm_ + tokb * 512 + h * 64);
    const unsigned kn_vo = (unsigned)(s_row * 512 + s_part * 8) * 2u, kr_vo = (unsigned)(r_row * 32 + r_part * 8) * 2u, v_vo = kn_vo;
    const ldsp Kl = lds, Vl = lds + 4 * KBUF;
    const int vtb = (4 * hi + ((lane & 15) >> 2)) * VR + (16 * ((lane >> 4) & 1) + 4 * (lane & 3)) * 2;
    u32x4 rk, rv, rr = (u32x4){0u, 0u, 0u, 0u};
#define MLA_LDK(t_) do { const unsigned tt_ = (unsigned)((t_) + rot) & (NT - 1); unsigned long long pk_ = (unsigned long long)(kn_base + (size_t)tt_ * (64 * 512 * 2)), pr_ = (unsigned long long)(kr_base + (size_t)tt_ * (64 * 32 * 2)); \
        asm volatile("" : "+s"(pk_), "+s"(pr_)); rk = *(const u32x4*)(gptr<const char>(pk_) + kn_vo); rr = *(const u32x4*)(gptr<const char>(pr_) + kr_vo); } while (0)
#define MLA_LDV(t_) do { const unsigned tt_ = (unsigned)((t_) + rot) & (NT - 1); unsigned long long pv_ = (unsigned long long)(v_base + (size_t)tt_ * (64 * 512 * 2)); asm volatile("" : "+s"(pv_)); rv = *(const u32x4*)(gptr<const char>(pv_) + v_vo); } while (0)
#define MLA_STK(buf) do { *(LAS u32x4*)(Kl + (buf) * KBUF + s_row * KSTR + s_part * 16) = rk; \
        *(LAS u32x4*)(Kl + (buf) * KBUF + r_row * KSTR + 128 + r_part * 16) = rr; } while (0)
#define MLA_STV(buf) do { *(LAS u32x4*)(Vl + (buf) * VBUF2 + s_row * VR + s_part * 16) = rv; } while (0)
    {
        u32x4 k0_, r0_, k1_, r1_, k2_, r2_, v0_;
        MLA_LDK(0); k0_ = rk; r0_ = rr; MLA_LDK(1); k1_ = rk; r1_ = rr; MLA_LDK(2); k2_ = rk; r2_ = rr; MLA_LDV(0); v0_ = rv;
        rk = k0_; rr = r0_; MLA_STK(0); rk = k1_; rr = r1_; MLA_STK(1); rk = k2_; rr = r2_; MLA_STK(2); rv = v0_; MLA_STV(0);
    }
    for (int i = tid; i < VBUF2 / 4; i += NTHREADS) ((LAS unsigned*)(Vl + 3 * VBUF2))[i] = 0u;
    MLA_LDK(3); MLA_LDV(1);
    __syncthreads();
    f32x16 cA0 = negref, cA1 = negref, cB0, cB1;
    {
        const ldsp kb = Kl + q * KSTR + hi * 16;
#pragma unroll
        for (int d0 = 0; d0 < 6; ++d0) { cA0 = MFMA32(*(const LAS bf16x8*)(kb + d0 * 32), qf[d0], cA0); cA1 = MFMA32(*(const LAS bf16x8*)(kb + 32 * KSTR + d0 * 32), qf[d0], cA1); SBAR(); }
    }
    __syncthreads();
    u32x4 ppA[4];
#pragma unroll
    for (int k = 0; k < 4; ++k) ppA[k] = (u32x4){0u, 0u, 0u, 0u};
#define MLA_LOADF(g) do { if ((g) < 8) fr[(g) % 3] = vfrag_tr(vbp + ((g) & 1) * 64 + ((g) >> 1) * 16 * VR, 8 * VR); \
                          else fr[(g) % 3] = *(const LAS bf16x8*)(kbn + ((g) & 1) * 32 * KSTR + (((g) - 8) >> 1) * 32); } while (0)
#define MLA_GAP(g, c0, c1, n0, n1, pp, pc) do { \
        if ((g) < 8) { if ((g) & 1) o1 = MFMA32(fr[(g) % 3], __builtin_bit_cast(bf16x8, pp[(g) >> 1]), o1); else o0 = MFMA32(fr[(g) % 3], __builtin_bit_cast(bf16x8, pp[(g) >> 1]), o0); } \
        else if ((g) < 10) { if ((g) & 1) n1 = MFMA32(fr[(g) % 3], qf[0], ((f32x16){0.f,0.f,0.f,0.f,0.f,0.f,0.f,0.f,0.f,0.f,0.f,0.f,0.f,0.f,0.f,0.f})); else n0 = MFMA32(fr[(g) % 3], qf[0], ((f32x16){0.f,0.f,0.f,0.f,0.f,0.f,0.f,0.f,0.f,0.f,0.f,0.f,0.f,0.f,0.f,0.f})); } \
        else { if ((g) & 1) n1 = MFMA32(fr[(g) % 3], qf[((g) - 8) >> 1], n1); else n0 = MFMA32(fr[(g) % 3], qf[((g) - 8) >> 1], n0); } \
        if ((g) + 2 < 20) MLA_LOADF((g) + 2); \
        if ((g) >= 4 && (g) < 12) { c0[2 * ((g) - 4)] = __builtin_amdgcn_exp2f(c0[2 * ((g) - 4)]); c0[2 * ((g) - 4) + 1] = __builtin_amdgcn_exp2f(c0[2 * ((g) - 4) + 1]); lsA += c0[2 * ((g) - 4)]; lsA += c0[2 * ((g) - 4) + 1]; \
            pc[((g) - 4) >> 2][((g) - 4) & 3] = pk2(c0[2 * ((g) - 4)], c0[2 * ((g) - 4) + 1]); } \
        else if ((g) >= 12) { c1[2 * ((g) - 12)] = __builtin_amdgcn_exp2f(c1[2 * ((g) - 12)]); c1[2 * ((g) - 12) + 1] = __builtin_amdgcn_exp2f(c1[2 * ((g) - 12) + 1]); lsA += c1[2 * ((g) - 12)]; lsA += c1[2 * ((g) - 12) + 1]; \
            pc[((g) - 4) >> 2][((g) - 4) & 3] = pk2(c1[2 * ((g) - 12)], c1[2 * ((g) - 12) + 1]); } \
        SBAR(); } while (0)
#define MLA_STEP(t_, c0, c1, n0, n1, pp, pc, BAR) do { \
        MLA_STK(((t_) + 3) & 3); MLA_STV(((t_) + 1) & 3); MLA_LDK((t_) + 4); MLA_LDV((t_) + 2); \
        const ldsp kbn = Kl + (((t_) + 1) & 3) * KBUF + q * KSTR + hi * 16; \
        const ldsp vbp = Vl + (((t_) + 3) & 3) * VBUF2 + vtb; \
        bf16x8 fr[3]; MLA_LOADF(0); MLA_LOADF(1); SBAR(); \
        MLA_GAP(0, c0, c1, n0, n1, pp, pc); MLA_GAP(1, c0, c1, n0, n1, pp, pc); MLA_GAP(2, c0, c1, n0, n1, pp, pc); MLA_GAP(3, c0, c1, n0, n1, pp, pc); \
        MLA_GAP(4, c0, c1, n0, n1, pp, pc); MLA_GAP(5, c0, c1, n0, n1, pp, pc); MLA_GAP(6, c0, c1, n0, n1, pp, pc); MLA_GAP(7, c0, c1, n0, n1, pp, pc); \
        MLA_GAP(8, c0, c1, n0, n1, pp, pc); MLA_GAP(9, c0, c1, n0, n1, pp, pc); MLA_GAP(10, c0, c1, n0, n1, pp, pc); MLA_GAP(11, c0, c1, n0, n1, pp, pc); \
        MLA_GAP(12, c0, c1, n0, n1, pp, pc); MLA_GAP(13, c0, c1, n0, n1, pp, pc); MLA_GAP(14, c0, c1, n0, n1, pp, pc); MLA_GAP(15, c0, c1, n0, n1, pp, pc); \
        MLA_GAP(16, c0, c1, n0, n1, pp, pc); MLA_GAP(17, c0, c1, n0, n1, pp, pc); MLA_GAP(18, c0, c1, n0, n1, pp, pc); MLA_GAP(19, c0, c1, n0, n1, pp, pc); \
        asm volatile("" : "+v"(n0), "+v"(n1), "+v"(o0), "+v"(o1));        \
        if (BAR) __syncthreads(); } while (0)
#pragma unroll 1
    for (int t = 0; t < NT; t += 2) {
        MLA_STEP(t, cA0, cA1, cB0, cB1, ppA, ppA, false);
        MLA_STEP(t + 1, cB0, cB1, cA0, cA1, ppA, ppA, true);
    }
    {
        const ldsp vb = Vl + ((NT - 1) & 3) * VBUF2 + vtb;
#pragma unroll
        for (int kk = 0; kk < 4; ++kk) { o0 = MFMA32(vfrag_tr(vb + kk * 16 * VR, 8 * VR), __builtin_bit_cast(bf16x8, ppA[kk]), o0); o1 = MFMA32(vfrag_tr(vb + 64 + kk * 16 * VR, 8 * VR), __builtin_bit_cast(bf16x8, ppA[kk]), o1); SBAR(); }
    }
    __syncthreads();
#undef MLA_LDK
#undef MLA_LDV
#undef MLA_STK
#undef MLA_STV
#undef MLA_LOADF
#undef MLA_GAP
#undef MLA_STEP
    float lsum = lsA + lsB;
    lsum = xor32_sum(lsum);
    const float il = 1.f / lsum;
    int lane2 = lane_id_v(); asm volatile("" : "+v"(lane2));
    const size_t tq2 = (size_t)b * SEQ + qb * 256 + wid * 32 + (lane2 & 31);
    bf16_t* dst = OC_ + tq2 * 1024 + 512 + h * 64 + 4 * (lane2 >> 5);
#pragma unroll
    for (int g = 0; g < 4; ++g) {
        *(u32x2*)(dst + 8 * g) = pack4((f32x4){o0[4 * g] * il, o0[4 * g + 1] * il, o0[4 * g + 2] * il, o0[4 * g + 3] * il});
        *(u32x2*)(dst + 32 + 8 * g) = pack4((f32x4){o1[4 * g] * il, o1[4 * g + 1] * il, o1[4 * g + 2] * il, o1[4 * g + 3] * il});
    }
}

DI void mla_unit_slow(ldsp lds, int b, int h, int qb, const bf16_t* Qm_, const bf16_t* Kn_, const bf16_t* Kr_, const bf16_t* Vm_, bf16_t* OC_, float ref, const int tid) {
    const int lane = tid & 63, wid = tid >> 6, q = lane & 31, hi = lane >> 5;
    const size_t tokb = (size_t)b * SEQ;
    const size_t tq = tokb + qb * 256 + wid * 32 + q;
    bf16x8 qf[6];
#pragma unroll
    for (int d0 = 0; d0 < 6; ++d0) qf[d0] = *(const bf16x8*)(Qm_ + tq * 768 + h * 96 + d0 * 16 + hi * 8);
    f32x16 o0, o1;
#pragma unroll
    for (int r = 0; r < 16; ++r) { o0[r] = 0.f; o1[r] = 0.f; }
    float lsum = 0.f;
    const int s_row = tid >> 3, s_part = tid & 7, r_row = (tid >> 2) & 63, r_part = tid & 3;
    const bf16_t* kn_src = Kn_ + (tokb + s_row) * 512 + h * 64 + s_part * 8;
    const bf16_t* v_src = Vm_ + (tokb + s_row) * 512 + h * 64 + s_part * 8;
    const bf16_t* kr_src = Kr_ + (tokb + r_row) * 32 + r_part * 8;
    const ldsp Kl = lds, Vl = lds + 2 * KBUF;
    u32x4 rk, rv, rr = (u32x4){0u, 0u, 0u, 0u};
    rk = *(const u32x4*)kn_src; rv = *(const u32x4*)v_src; if (tid < 256) rr = *(const u32x4*)kr_src;
#define MLA_STORE(buf) do { \
        *(LAS u32x4*)(Kl + (buf) * KBUF + s_row * KSTR + s_part * 16) = rk; \
        if (tid < 256) *(LAS u32x4*)(Kl + (buf) * KBUF + r_row * KSTR + 128 + r_part * 16) = rr; \
        LAS unsigned short* vt_ = (LAS unsigned short*)(Vl + (buf) * VBUF) + (s_part * 8) * (VSTR / 2) + s_row; \
        _Pragma("unroll") for (int j_ = 0; j_ < 8; ++j_) vt_[j_ * (VSTR / 2)] = (unsigned short)(rv[j_ >> 1] >> (16 * (j_ & 1))); } while (0)
    MLA_STORE(0);
    __syncthreads();
    for (int t = 0; t < SEQ / 64; ++t) {
        const int cur = t & 1;
        if (t + 1 < SEQ / 64) { const size_t off = (size_t)(t + 1) * 64;
            rk = *(const u32x4*)(kn_src + off * 512); rv = *(const u32x4*)(v_src + off * 512); if (tid < 256) rr = *(const u32x4*)(kr_src + off * 32); }
        f32x16 s0, s1;
#pragma unroll
        for (int r = 0; r < 16; ++r) { s0[r] = -ref; s1[r] = -ref; }
        const ldsp kb = Kl + cur * KBUF + q * KSTR + hi * 16;
#pragma unroll
        for (int d0 = 0; d0 < 6; ++d0) {
            const bf16x8 a0 = *(const LAS bf16x8*)(kb + d0 * 32);
            const bf16x8 a1 = *(const LAS bf16x8*)(kb + 32 * KSTR + d0 * 32);
            s0 = MFMA32(a0, qf[d0], s0); s1 = MFMA32(a1, qf[d0], s1);
        }
#pragma unroll
        for (int r = 0; r < 16; ++r) { s0[r] = __builtin_amdgcn_exp2f(s0[r]); s1[r] = __builtin_amdgcn_exp2f(s1[r]); }
        float ps = 0.f;
#pragma unroll
        for (int r = 0; r < 16; ++r) ps += s0[r] + s1[r];
        lsum += ps;
        bf16x8 pf[4]; pf[0] = pack8(s0, 0); pf[1] = pack8(s0, 1); pf[2] = pack8(s1, 0); pf[3] = pack8(s1, 1);
        const ldsp vb = Vl + cur * VBUF + q * VSTR + hi * 8;
#pragma unroll
        for (int kk = 0; kk < 4; ++kk) {
            o0 = MFMA32(vfrag(vb + kk * 32), pf[kk], o0);
            o1 = MFMA32(vfrag(vb + 32 * VSTR + kk * 32), pf[kk], o1);
        }
        if (t + 1 < SEQ / 64) MLA_STORE(cur ^ 1);
        __syncthreads();
    }
#undef MLA_STORE
    lsum = xor32_sum(lsum);
    const float il = 1.f / lsum;
    bf16_t* dst = OC_ + tq * 1024 + 512 + h * 64 + 4 * hi;
#pragma unroll
    for (int g = 0; g < 4; ++g) {
        *(u32x2*)(dst + 8 * g) = pack4((f32x4){o0[4 * g] * il, o0[4 * g + 1] * il, o0[4 * g + 2] * il, o0[4 * g + 3] * il});
        *(u32x2*)(dst + 32 + 8 * g) = pack4((f32x4){o1[4 * g] * il, o1[4 * g + 1] * il, o1[4 * g + 2] * il, o1[4 * g + 3] * il});
    }
}


constexpr int VS2 = 96;
typedef int i32x4 __attribute__((ext_vector_type(4)));
DI void dil_task(ldsp vscr, ldsp pscr, const int* pos, int cfg, int dil, int b, int h, int T0, int k, const bf16_t* Qd, const bf16_t* Kd, const bf16_t* Vd,
                 bf16_t* PART, float* LP, bf16_t* OC, float ref, float slope_l2, int lane) {
    const int tpr = 16 / dil, rs = k / tpr, sub = k % tpr, L = SEQ / dil, U0 = T0 / dil + 32 * sub;
    const int q = lane & 31, hi = lane >> 5;
    const size_t tokb = (size_t)b * SEQ;
    const size_t tq = tokb + rs + (size_t)dil * (U0 + q);
    const int lrow0 = lane >> 3, lch0 = lane & 7;
    const ldsp qscr = vscr + 32 * 192;
    {   u32x4 qc[4];
#pragma unroll
        for (int i = 0; i < 4; ++i) qc[i] = *(const u32x4*)(Qd + (tokb + rs + (size_t)dil * (U0 + 8 * i + lrow0)) * 512 + h * 64 + 8 * lch0);
#pragma unroll
        for (int i = 0; i < 4; ++i) *(LAS u32x4*)(qscr + (8 * i + lrow0) * 144 + lch0 * 16) = qc[i]; }
    bf16x8 qf[4];
#pragma unroll
    for (int d0 = 0; d0 < 4; ++d0) qf[d0] = *(const LAS bf16x8*)(qscr + q * 144 + d0 * 32 + hi * 16);
    f32x16 o0, o1;
#pragma unroll
    for (int r = 0; r < 16; ++r) { o0[r] = 0.f; o1[r] = 0.f; }
    float lsum = 0.f;
    const int posq = pos[tq];
    u32x4 kc[4], kn[4], vv[4], vvn[4]; int pk, pkn;
    const int lrow = lane >> 3, lch = lane & 7;
    const ldsp kscr = vscr + 32 * 192;
#define DIL_LOAD(KC, VV, PK, t_) do { const int Ut_ = U0 - 64 + 32 * (t_); \
        _Pragma("unroll") for (int i = 0; i < 4; ++i) { int uk_ = Ut_ + 8 * i + lrow; uk_ = uk_ < 0 ? 0 : (uk_ > L - 1 ? L - 1 : uk_); \
            const size_t tk_ = tokb + rs + (size_t)dil * uk_; \
            KC[i] = *(const u32x4*)(Kd + tk_ * 512 + h * 64 + 8 * lch); VV[i] = *(const u32x4*)(Vd + tk_ * 512 + h * 64 + 8 * lch); } \
        { int ukl_ = Ut_ + q; ukl_ = ukl_ < 0 ? 0 : (ukl_ > L - 1 ? L - 1 : ukl_); PK = pos[tokb + rs + (size_t)dil * ukl_]; } } while (0)
    DIL_LOAD(kc, vv, pk, 0);
#pragma unroll 1
    for (int t = 0; t < 5; ++t) {
        const int Ut = U0 - 64 + 32 * t;
        if (t < 4) DIL_LOAD(kn, vvn, pkn, t + 1);
        if (!(Ut + 31 < 0 || Ut >= L)) {
#pragma unroll
        for (int i = 0; i < 4; ++i) { *(LAS u32x4*)(vscr + (8 * i + lrow) * 192 + lch * 16) = vv[i]; *(LAS u32x4*)(kscr + (8 * i + lrow) * 144 + lch * 16) = kc[i]; }
        f32x16 s;
#pragma unroll
        for (int r = 0; r < 16; ++r) s[r] = -ref;
#pragma unroll
        for (int d0 = 0; d0 < 4; ++d0) s = MFMA32(*(const LAS bf16x8*)(kscr + q * 144 + d0 * 32 + hi * 16), qf[d0], s);
        float ps = 0.f;
        if (hi == 0) ((LAS int*)pscr)[q] = pk;
        i32x4 pk4[4];
#pragma unroll
        for (int g = 0; g < 4; ++g) pk4[g] = *(const LAS i32x4*)(pscr + (8 * g + 4 * hi) * 4);
        const float fbase = (float)(Ut - U0 - q + 4 * hi);
        const bool interior = (Ut >= 0) && (Ut + 31 < L);
#pragma unroll
        for (int r = 0; r < 16; ++r) {
            const float fd = fbase + (float)((r & 3) + 8 * (r >> 2));
            const float dist = (float)(pk4[r >> 2][r & 3] - posq);
            const float e = __builtin_amdgcn_exp2f(__builtin_fmaf(-slope_l2, __builtin_fabsf(dist), s[r]));
            bool valid = __builtin_fabsf(fd) <= 64.f;
            if (!interior) { const int uk = Ut + crow(r, hi); valid = valid && (uk >= 0) && (uk < L); }
            const float p = valid ? e : 0.f;
            s[r] = p; ps += p;
        }
        lsum += ps;
        const bf16x8 pf0 = pack8(s, 0), pf1 = pack8(s, 1);
        const ldsp vb = vscr + (4 * hi + ((lane & 15) >> 2)) * 192 + (16 * ((lane >> 4) & 1) + 4 * (lane & 3)) * 2;
        o0 = MFMA32(vfrag_tr(vb, 8 * 192), pf0, o0);
        o0 = MFMA32(vfrag_tr(vb + 16 * 192, 8 * 192), pf1, o0);
        o1 = MFMA32(vfrag_tr(vb + 64, 8 * 192), pf0, o1);
        o1 = MFMA32(vfrag_tr(vb + 64 + 16 * 192, 8 * 192), pf1, o1);
        }
#pragma unroll
        for (int i = 0; i < 4; ++i) { kc[i] = kn[i]; vv[i] = vvn[i]; }
        pk = pkn;
    }
#undef DIL_LOAD
    lsum = xor32_sum(lsum);
    {
        const ldsp oscr = vscr;
#pragma unroll
        for (int g = 0; g < 4; ++g) {
            *(LAS f32x4*)(oscr + q * 272 + (8 * g + 4 * hi) * 4) = (f32x4){o0[4 * g], o0[4 * g + 1], o0[4 * g + 2], o0[4 * g + 3]};
            *(LAS f32x4*)(oscr + q * 272 + (32 + 8 * g + 4 * hi) * 4) = (f32x4){o1[4 * g], o1[4 * g + 1], o1[4 * g + 2], o1[4 * g + 3]};
        }
        if (hi == 0) ((LAS float*)(oscr + 8704))[q] = lsum;
#pragma unroll
        for (int i = 0; i < 4; ++i) {
            const int row = 8 * i + lrow0;
            const size_t tr = tokb + rs + (size_t)dil * (U0 + row);
            const f32x4 a0 = *(const LAS f32x4*)(oscr + row * 272 + lch0 * 32), a1 = *(const LAS f32x4*)(oscr + row * 272 + lch0 * 32 + 16);
            const float lrw = ((const LAS float*)(oscr + 8704))[row];
            if (cfg < 2) {
                u32x4 w; w.x = pk2(a0[0], a0[1]); w.y = pk2(a0[2], a0[3]); w.z = pk2(a1[0], a1[1]); w.w = pk2(a1[2], a1[3]);
                *(u32x4*)(PART + ((size_t)cfg * MTOK + tr) * 512 + h * 64 + 8 * lch0) = w;
                if (lch0 == 0) LP[((size_t)cfg * MTOK + tr) * 8 + h] = lrw;
            } else {
                const u32x4 p0 = *(const u32x4*)(PART + tr * 512 + h * 64 + 8 * lch0), p1 = *(const u32x4*)(PART + ((size_t)MTOK + tr) * 512 + h * 64 + 8 * lch0);
                const float il = 1.f / (lrw + LP[tr * 8 + h] + LP[((size_t)MTOK + tr) * 8 + h]);
                float v[8];
#pragma unroll
                for (int e = 0; e < 8; ++e) { const unsigned aw = p0[e >> 1], cw = p1[e >> 1];
                    const float av = __uint_as_float((e & 1) ? (aw & 0xffff0000u) : (aw << 16)), cv = __uint_as_float((e & 1) ? (cw & 0xffff0000u) : (cw << 16));
                    v[e] = ((e < 4 ? a0[e & 3] : a1[e & 3]) + av + cv) * il; }
                u32x4 w; w.x = pk2(v[0], v[1]); w.y = pk2(v[2], v[3]); w.z = pk2(v[4], v[5]); w.w = pk2(v[6], v[7]);
                *(u32x4*)(OC + tr * 1024 + h * 64 + 8 * lch0) = w;
            }
        }
    }
}

__global__ void __launch_bounds__(NTHREADS, 2) mega_fwd(Params P) {
    extern __shared__ __attribute__((aligned(16))) unsigned char lds_raw[];
    cg::grid_group grid = cg::this_grid();
    const ldsp lds = (ldsp)lds_raw;
    const int G0 = gridDim.x, blk0 = blockIdx.x;
    const int wid_s = __builtin_amdgcn_readfirstlane((int)threadIdx.x >> 6);
    { int lane0 = lane_id_v(); const int tid0 = wid_s * 64 + lane0;
      volatile LAS unsigned* st = (volatile LAS unsigned*)(lds + LDS_BYTES - 16);
      if (tid0 == 0) { st[0] = 0u; st[1] = 0u; }
      __syncthreads();
      (void)xcd_barrier_post((unsigned*)(PF(ws) + WS_BAR), st, tid0); }
#define GSYNC() do { int w_ = wid_s; asm volatile("" : "+s"(w_)); int l_ = lane_id_v(); asm volatile("" : "+v"(l_)); \
    XcdBarrier xb_; xb_.bar = (unsigned*)(PF(ws) + WS_BAR); xb_.x = xb_xcc_id(); xb_.st = (volatile LAS unsigned*)(lds + LDS_BYTES - 16); xcd_barrier(xb_, w_ * 64 + l_); } while (0)
#define PHASE_BEGIN() int blk = blk0, G = G0; asm volatile("" : "+s"(blk), "+s"(G)); int wid = wid_s; asm volatile("" : "+s"(wid)); int lane = lane_id_v(); asm volatile("" : "+v"(lane)); const int tid = wid * 64 + lane; \
    unsigned long long wsv_ = karg_u64((int)__builtin_offsetof(Params, ws)); asm volatile("" : "+s"(wsv_)); unsigned char* ws = gptr<unsigned char>(wsv_); const int gw = blk * 8 + wid, NGW = G * 8; (void)lane; (void)gw; (void)NGW
#define MOD ((float*)(ws + WS_MOD))
#define BIAS1 ((float*)(ws + WS_BIAS1))
#define BIAS2 ((float*)(ws + WS_BIAS2))
#define GS1 ((float*)(ws + WS_GS1))
#define GS2 ((float*)(ws + WS_GS2))
#define XA ((bf16_t*)(ws + WS_XA))
#define Qd ((bf16_t*)(ws + WS_QD))
#define Kd ((bf16_t*)(ws + WS_KD))
#define Vd ((bf16_t*)(ws + WS_VD))
#define Qm ((bf16_t*)(ws + WS_QM))
#define Kn ((bf16_t*)(ws + WS_KN))
#define Vm ((bf16_t*)(ws + WS_VM))
#define OC ((bf16_t*)(ws + WS_OC))
#define Kr ((bf16_t*)(ws + WS_KR))
#define CQ ((bf16_t*)(ws + WS_CQ))
#define CKV ((bf16_t*)(ws + WS_CKV))
#define PART ((bf16_t*)(ws + WS_PART))
#define LP ((float*)(ws + WS_LP))
#define SSQX ((float*)(ws + WS_SSQX))
#define SSQ2 ((float*)(ws + WS_SSQ2))
#define SSQCQ ((float*)(ws + WS_SSQCQ))
#define SSQCKV ((float*)(ws + WS_SSQCKV))
#define HB ((bf16_t*)(ws + WS_H))
#define RCOS ((float*)(ws + WS_RCOS))
#define RSIN ((float*)(ws + WS_RSIN))
#define WL(off) (ws + WS_W + (size_t)l * WS_WSTRIDE + (off))

    {
    PHASE_BEGIN();
    LAS float* vecs = (LAS float*)lds; LAS float* red = (LAS float*)(lds + 8192); LAS float* tscr = (LAS float*)(lds + 16384 + wid * 8704);
    if ((PH_MASK & 1) && (blk < 192 || G < 192)) {
        for (int i = tid; i < 2048; i += NTHREADS) { const float cv = PF(c)[i]; vecs[i] = cv / (1.f + __expf(-cv)); }
        __syncthreads();
        for (int u = blk; u < 192; u += G) { const int l = u / 96, nb = u % 96;
            gemv_unit(PF(w_mod) + (size_t)l * DM * 6144, 6144, 6144, nb, vecs, red, MOD + (l * 2 + 0) * 6144, MOD + (l * 2 + 1) * 6144, PF(b_mod) + l * 6144, tid); }
    }
    for (int i = blk * NTHREADS + tid; i < MTOK * 16; i += G * NTHREADS) {
        float sn, cs; sincos_rev((float)PF(pos)[i >> 4] * c_inv[i & 15], sn, cs); RCOS[i] = cs; RSIN[i] = sn; }
    if (PH_MASK & 2) {
        constexpr int I_IN = 16 * 64, I_QU = 4 * 24, I_KV = 2 * 32, I_OUT = 16 * 32, I_W1 = 16 * 128, I_W2 = 64 * 32, I_L = I_IN + I_QU + I_KV + I_OUT + I_W1 + I_W2;
        for (int it = gw; it < 2 * I_L; it += NGW) {
            const int l = it / I_L; int r = it % I_L;
            unsigned char* wl = ws + WS_W + (size_t)l * WS_WSTRIDE;
            if (r < I_IN) { transpose_item(PF(w_in) + (size_t)l * DM * WIN_COLS, DM, WIN_COLS, 64, (bf16_t*)(wl + WO_IN), nullptr, tscr, r, lane,
                    [](int Gp) { const int pn = Gp >> 3, bj = (Gp >> 2) & 1, wc = Gp & 3; const int lb = 256 * pn + 64 * wc + 32 * bj; return lb < WIN_COLS ? lb : -1; }); continue; }
            r -= I_IN;
            if (r < I_QU) { transpose_item(PF(w_q_up) + (size_t)l * 256 * 768, 256, 768, 24, (bf16_t*)(wl + WO_QU), PF(g_cq) + l * 256, tscr, r, lane,
                    [](int Gp) { const int pn = Gp >> 3, bj = (Gp >> 2) & 1, wc = Gp & 3; return pn < 2 ? (4 * pn + wc) * 96 + 32 * bj : (2 * wc + bj) * 96 + 64; }); continue; }
            r -= I_QU;
            if (r < I_KV) { transpose_item(PF(w_kv_up) + (size_t)l * 128 * 1024, 128, 1024, 32, (bf16_t*)(wl + WO_KV), PF(g_ckv) + l * 128, tscr, r, lane,
                    [](int Gp) { const int pn = Gp >> 3, bj = (Gp >> 2) & 1, wc = Gp & 3; return pn < 2 ? (4 * pn + wc) * 128 + 32 * bj : (4 * (pn - 2) + wc) * 128 + 64 + 32 * bj; }); continue; }
            r -= I_KV;
            if (r < I_OUT) { transpose_item(PF(w_out) + (size_t)l * DM * DM, DM, DM, 32, (bf16_t*)(wl + WO_OUT), nullptr, tscr, r, lane, [](int Gp) { return 32 * Gp; }); continue; }
            r -= I_OUT;
            if (r < I_W1) { transpose_item(PF(w_mlp_in) + (size_t)l * DM * FF, DM, FF, 128, (bf16_t*)(wl + WO_W1), nullptr, tscr, r, lane, [](int Gp) { return 32 * Gp; }); continue; }
            r -= I_W1;
            transpose_item(PF(w_mlp_out) + (size_t)l * FF * DM, FF, DM, 32, (bf16_t*)(wl + WO_W2), nullptr, tscr, r, lane, [](int Gp) { return 32 * Gp; });
        }
    }
    }
    GSYNC();
    if (G0 > (1 << 24)) grid.sync();

    {
    PHASE_BEGIN();
    LAS float* vecs = (LAS float*)lds; LAS float* red = (LAS float*)(lds + 8192);
    if (PH_MASK & 4) for (int u = blk; u < 192; u += G) {
        const int l = u / 96, rem = u % 96; const bool first = rem < 32;
        const int sh_off = first ? 0 : 3072;
        __syncthreads();
        for (int i = tid; i < 2048; i += NTHREADS) vecs[i] = MOD[(l * 2 + (i >> 10)) * 6144 + sh_off + (i & 1023)];
        __syncthreads();
        if (first) gemv_unit(PF(w_in) + (size_t)l * DM * WIN_COLS, WIN_COLS, WIN_PAD, rem, vecs, red, BIAS1 + (l * 2 + 0) * WIN_PAD, BIAS1 + (l * 2 + 1) * WIN_PAD, nullptr, tid);
        else gemv_unit(PF(w_mlp_in) + (size_t)l * DM * FF, FF, FF, rem - 32, vecs, red, BIAS2 + (l * 2 + 0) * FF, BIAS2 + (l * 2 + 1) * FF, nullptr, tid);
    }
    if (blk == G - 1 && tid < 2) {
        const int l = tid;
        float Gq = 0.f, Gk = 0.f, Gqn = 0.f, Gkn = 0.f, Gqr = 0.f, Gkr = 0.f;
#pragma unroll 1
        for (int i = 0; i < 64; ++i) { Gq = fmaxf(Gq, fabsf(PF(g_q_dil)[l * 64 + i])); Gk = fmaxf(Gk, fabsf(PF(g_k_dil)[l * 64 + i]));
            Gqn = fmaxf(Gqn, fabsf(PF(g_q_nope)[l * 64 + i])); Gkn = fmaxf(Gkn, fabsf(PF(g_k_nope)[l * 64 + i])); }
#pragma unroll 1
        for (int i = 0; i < 32; ++i) { Gqr = fmaxf(Gqr, fabsf(PF(g_q_rope)[l * 32 + i])); Gkr = fmaxf(Gkr, fabsf(PF(g_k_rope)[l * 32 + i])); }
        ((float*)(ws + WS_REFS))[l * 2 + 0] = 64.f * Gq * Gk * QS_D;
        ((float*)(ws + WS_REFS))[l * 2 + 1] = (64.f * Gqn * Gkn + 32.f * Gqr * Gkr) * QS_M;
    }
    for (int i = blk * NTHREADS + tid; i < 4096; i += G * NTHREADS) {
        const int lb = i >> 10, c = i & 1023, l = lb >> 1;
        GS1[i] = PF(g_norm_mix)[l * DM + c] * (1.f + MOD[lb * 6144 + 1024 + c]);
        GS2[i] = PF(g_norm_mlp)[l * DM + c] * (1.f + MOD[lb * 6144 + 4096 + c]);
    }
    for (int m0 = 4 * gw; m0 < MTOK; m0 += 4 * NGW) {
        f32x4 xv[4][4];
#pragma unroll
        for (int r = 0; r < 4; ++r)
#pragma unroll
            for (int j = 0; j < 4; ++j) xv[r][j] = *(const f32x4*)(PF(x) + (size_t)(m0 + r) * DM + 4 * lane + 256 * j);
        const int b = m0 >> 13;
#pragma unroll
        for (int r = 0; r < 4; ++r) { const int m = m0 + r; float s = 0.f;
#pragma unroll
            for (int j = 0; j < 4; ++j) { const int c = 4 * lane + 256 * j;
                const f32x4 v = xv[r][j], gg = *(const f32x4*)(PF(g_norm_mix) + c), sc = *(const f32x4*)(MOD + b * 6144 + 1024 + c);
                s += sq4(v); *(u32x2*)(XA + (size_t)m * DM + c) = pack4(v * gg * (sc + 1.f)); }
            s = wave_sum(s);
            if (lane < 16) SSQX[(size_t)m * 16 + lane] = lane == 0 ? s : 0.f; }
    }
    }
    GSYNC();

#pragma unroll 1
    for (int l = 0; l < 2; ++l) {
        if (PH_MASK & 8) {
            PHASE_BEGIN();
            pg8::Gemm g{XA, (const bf16_t*)WL(WO_IN), MTOK, WIN_PAD, DM}; pg8::StaticOrder S; S.init(MTOK, WIN_PAD, G, blk);
            EpiIn E{ws, BIAS1 + (size_t)l * 2 * WIN_PAD, PF(g_q_dil) + l * 64, PF(g_k_dil) + l * 64, PF(g_k_rope) + l * 32};
            pg8::gemm_phase<EpiIn, pg8::StaticOrder, true, true>(lds, g, S, E, tid);
        }
        GSYNC();
        if (PH_MASK & 16) {
            PHASE_BEGIN();
            int Kq = 256; asm volatile("" : "+s"(Kq));
            pg8::Gemm g{CQ, (const bf16_t*)WL(WO_QU), MTOK, 768, Kq}; pg8::StaticOrder S; S.init(MTOK, 768, G, blk);
            EpiQup E{SSQCQ, PF(g_q_nope) + l * 64, PF(g_q_rope) + l * 32, RCOS, RSIN, Qm};
            pg8::gemm_phase<EpiQup, pg8::StaticOrder, true, true>(lds, g, S, E, tid);
        }
        __syncthreads();
        if (PH_MASK & 32) {
            PHASE_BEGIN();
            int Kk = 128; asm volatile("" : "+s"(Kk));
            pg8::Gemm g{CKV, (const bf16_t*)WL(WO_KV), MTOK, 1024, Kk}; pg8::StaticOrder S; S.init(MTOK, 1024, G, blk);
            EpiKvup E{SSQCKV, PF(g_k_nope) + l * 64, Kn, Vm};
            pg8::gemm_phase<EpiKvup, pg8::StaticOrder, true, true>(lds, g, S, E, tid);
        }
        GSYNC();
        {
            PHASE_BEGIN();
            const float ref_d = ((const float*)(ws + WS_REFS))[l * 2 + 0], ref_m = ((const float*)(ws + WS_REFS))[l * 2 + 1];
            if (PH_MASK & 64) for (int u = blk; u < 256; u += G) {
                const int h = u & 7, tb = (u >> 3) & 15, b = u >> 7;
                const float slope_l2 = LOG2E / (float)(1 << (h + 1));
                const ldsp vscr = lds + wid * 10752;
#pragma unroll 1
                for (int cfg = 0; cfg < 3; ++cfg) {
                    if (cfg == 2) __syncthreads();
                    const int dil = cfg == 0 ? 1 : (cfg == 1 ? 4 : 16);
#pragma unroll 1
                    for (int k = wid; k < 16; k += 8) dil_task(vscr, lds + 8 * 10752 + wid * 128, PF(pos), cfg, dil, b, h, tb * 512, k, Qd, Kd, Vd, PART, LP, OC, ref_d, slope_l2, lane);
                }
                __syncthreads();
            }
            if (ref_m < 100.f) {
                for (int u = blk; u < 512; u += G) { const int x = u & 7, j = (u >> 3) & 31, i = u >> 8, bh = 2 * x + i;
                    mla_unit(lds, bh >> 3, bh & 7, j, Qm, Kn, Kr, Vm, OC, 0.f, wid); }
            } else {
                for (int u = blk; u < 512; u += G) { const int x = u & 7, j = (u >> 3) & 31, i = u >> 8, bh = 2 * x + i;
                    mla_unit_slow(lds, bh >> 3, bh & 7, j, Qm, Kn, Kr, Vm, OC, ref_m, tid); }
            }
        }
        GSYNC();
        if (PH_MASK & 256) {
            PHASE_BEGIN();
            pg8::Gemm g{OC, (const bf16_t*)WL(WO_OUT), MTOK, DM, DM}; pg8::StaticOrder S; S.init(MTOK, DM, G, blk);
            EpiRes E{l == 0 ? PF(x) : (const float*)PF(out), PF(out), MOD + (size_t)l * 2 * 6144 + 2048, GS2 + (size_t)l * 2 * DM, XA, SSQ2};
            pg8::gemm_phase<EpiRes, pg8::StaticOrder, true, true>(lds, g, S, E, tid);
        }
        GSYNC();
        if (PH_MASK & 512) {
            PHASE_BEGIN();
            pg8::Gemm g{XA, (const bf16_t*)WL(WO_W1), MTOK, FF, DM}; pg8::StaticOrder S; S.init(MTOK, FF, G, blk);
            EpiUp E{SSQ2, BIAS2 + (size_t)l * 2 * FF, HB};
            pg8::gemm_phase<EpiUp, pg8::StaticOrder, true, true>(lds, g, S, E, tid);
        }
        GSYNC();
        if (PH_MASK & 1024) {
            PHASE_BEGIN();
            pg8::Gemm g{HB, (const bf16_t*)WL(WO_W2), MTOK, DM, FF}; pg8::StaticOrder S; S.init(MTOK, DM, G, blk);
            EpiRes E{(const float*)PF(out), PF(out), MOD + (size_t)l * 2 * 6144 + 5120, l == 0 ? GS1 + 2 * DM : nullptr, XA, SSQX};
            pg8::gemm_phase<EpiRes, pg8::StaticOrder, true, true>(lds, g, S, E, tid);
        }
        if (l == 0) GSYNC();
    }
}

extern "C" void kernel_launch(void* const* d_in, const int* in_sizes, int n_in, void* d_out, int out_size, void* d_ws, size_t ws_size, hipStream_t stream) {
    static int grid = 0;
    if (grid == 0) {
        if (n_in != 21 || ws_size < WS_END) { fprintf(stderr, "kernel_launch: unexpected n_in %d / ws_size %zu\n", n_in, ws_size); grid = -1; return; }
        int dev = 0, cus = 0, per_cu = 0;
        hipGetDevice(&dev);
        hipDeviceGetAttribute(&cus, hipDeviceAttributeMultiprocessorCount, dev);
        if (hipFuncSetAttribute((const void*)mega_fwd, hipFuncAttributeMaxDynamicSharedMemorySize, LDS_BYTES) != hipSuccess) { fprintf(stderr, "kernel_launch: hipFuncSetAttribute failed\n"); }
        if (hipOccupancyMaxActiveBlocksPerMultiprocessor(&per_cu, (const void*)mega_fwd, NTHREADS, LDS_BYTES) != hipSuccess || per_cu < 1) { fprintf(stderr, "kernel_launch: occupancy query says %d\n", per_cu); per_cu = 1; }
        (void)hipGetLastError();
        grid = cus;
        if (grid > 256) grid = 256;
    }
    if (grid < 0) return;
    Params p{};
    p.x = (const float*)d_in[0]; p.c = (const float*)d_in[1]; p.pos = (const int*)d_in[2]; p.w_mod = (const float*)d_in[3]; p.b_mod = (const float*)d_in[4];
    p.g_norm_mix = (const float*)d_in[5]; p.w_in = (const float*)d_in[6]; p.g_q_dil = (const float*)d_in[7]; p.g_k_dil = (const float*)d_in[8]; p.g_cq = (const float*)d_in[9];
    p.w_q_up = (const float*)d_in[10]; p.g_ckv = (const float*)d_in[11]; p.w_kv_up = (const float*)d_in[12]; p.g_q_nope = (const float*)d_in[13]; p.g_q_rope = (const float*)d_in[14];
    p.g_k_nope = (const float*)d_in[15]; p.g_k_rope = (const float*)d_in[16]; p.w_out = (const float*)d_in[17]; p.g_norm_mlp = (const float*)d_in[18];
    p.w_mlp_in = (const float*)d_in[19]; p.w_mlp_out = (const float*)d_in[20]; p.out = (float*)d_out; p.ws = (unsigned char*)d_ws;
    if (hipMemsetAsync((char*)d_ws + WS_BAR, 0, WS_BAR_BYTES, stream) != hipSuccess) { fprintf(stderr, "kernel_launch: memset failed\n"); return; }
    void* args[] = {&p};
    hipError_t e = hipLaunchCooperativeKernel((const void*)mega_fwd, dim3(grid), dim3(NTHREADS), args, LDS_BYTES, stream);
    if (e != hipSuccess) fprintf(stderr, "kernel_launch: cooperative launch failed: %s (grid %d)\n", hipGetErrorString(e), grid);
}
```

```cpp
#include <hip/hip_runtime.h>
#include <hip/hip_cooperative_groups.h>
#include <cstdio>
#include <cstdint>
namespace cg = cooperative_groups;
namespace pg8 {
#define PG8_LAS __attribute__((address_space(3)))
typedef unsigned short bf16_t;
typedef short bf16x8 __attribute__((ext_vector_type(8)));
typedef float f32x4 __attribute__((ext_vector_type(4)));
typedef unsigned u32x4 __attribute__((ext_vector_type(4)));
constexpr int BM = 256, BK = 64, HALF = 128, HTB = HALF * BK * 2  , STAGE_BYTES = 8 * HTB, NXCD = 8, WGM = 8;

__host__ __device__ __forceinline__ int lds_byte(int r, int c) { const int st = (r >> 4) * 2 + (c >> 5), rr = r & 15, cc = c & 31, ob = rr * 64 + cc * 2; return st * 1024 + (ob ^ (((ob >> 9) & 1) << 5)); }
__host__ __device__ __forceinline__ void stage_rc(int b, int& R, int& C) { const int st = b / 1024, sb = b % 1024, swz = sb ^ (((sb >> 9) & 1) << 5); R = (st >> 1) * 16 + swz / 64; C = (st & 1) * 32 + (swz % 64) / 2; }
__host__ __device__ __forceinline__ int perm32(int rho) { const int n = rho >> 4, i = rho & 15; return 8 * (i >> 2) + 4 * n + (i & 3); }

struct Unit { int pm, pn; };
struct Gemm { const bf16_t* A; const bf16_t* Bt; int M, N, K; };

struct StaticOrder {
    int nM, nN, nwg, G, c;
    __host__ __device__ void init(int M, int N, int G_, int c_) { nM = M / BM; nN = N / BM; nwg = nM * nN; G = G_; c = c_; }
    __host__ __device__ bool next(int i, Unit& u) const {
        const long L = (long)i * G + c; if (L >= nwg) return false;
        int wgid = (int)L; { const int q = nwg / NXCD, r = nwg % NXCD, xcd = wgid % NXCD, off = wgid / NXCD; wgid = (xcd < r ? xcd * (q + 1) : r * (q + 1) + (xcd - r) * q) + off; }
        const int nig = WGM * nN, gid = wgid / nig, fm = gid * WGM, gsz = (nM - fm) < WGM ? (nM - fm) : WGM;
        u.pm = fm + ((wgid % nig) % gsz); u.pn = (wgid % nig) / gsz; return true;
    }
    __device__ __forceinline__ void a_ready(const Unit&) const {}
    __device__ __forceinline__ void done(const Unit&) const {}
};

__device__ __forceinline__ unsigned cvt_pk_bf16(float lo, float hi) { unsigned r; asm volatile("v_cvt_pk_bf16_f32 %0, %1, %2" : "=v"(r) : "v"(lo), "v"(hi)); return r; }
template <class Epi, class Sched, bool ALIGN_EPI = false, bool SP2 = false>
__device__ __forceinline__ void gemm_phase(PG8_LAS unsigned char* lds, const Gemm g, const Sched& S, const Epi& E, const int tid_in) {
    int tid_ = tid_in; asm volatile("" : "+v"(tid_));
    const int tid = tid_, wid = __builtin_amdgcn_readfirstlane(tid >> 6), lane = tid & 63, wr = wid >> 2, wc = wid & 3, fr = lane & 15, fq = lane >> 4;
    const int K = g.K, nt = K / BK;
    unsigned voffA[2], voffB[2];
#pragma unroll
    for (int i = 0; i < 2; ++i) { int R, C; stage_rc(tid * 16 + i * 8192, R, C); const int Rb = Epi::PERM ? ((R & ~31) + perm32(R & 31)) : R;
        voffA[i] = (unsigned)(R * K + C) * 2u; voffB[i] = (unsigned)(Rb * K + C) * 2u; }
    const size_t kstep = (size_t)(BK * 2);
    const size_t hstep = (size_t)HALF * K * 2;
    const size_t tstep = 2 * hstep;
    const unsigned ldsw = (unsigned)wid * 1024u;
    const int aoff = lds_byte(wr * 64 + fr, fq * 8), boff = lds_byte(wc * 32 + fr, fq * 8);
#define PG8_SA(b, h) (((b) * 2 + (h)) * HTB)
#define PG8_SB(b, h) ((4 + (b) * 2 + (h)) * HTB)
#define PG8_STAGE(bufoff, gbase, voff) do { _Pragma("unroll") for (int _i = 0; _i < 2; ++_i) \
        __builtin_amdgcn_global_load_lds((const unsigned*)((const char*)(gbase) + (voff)[_i]), (PG8_LAS unsigned*)(lds + (bufoff) + ldsw + _i * 8192), 16, 0, 0); } while (0)
#define PG8_LDA(dst, b, h) do { _Pragma("unroll") for (int m = 0; m < 4; ++m) _Pragma("unroll") for (int k = 0; k < 2; ++k) dst[m][k] = *(const PG8_LAS bf16x8*)(lds + PG8_SA(b, h) + aoff + m * 2048 + k * 1024); } while (0)
#define PG8_LDB(dst, b, h) do { _Pragma("unroll") for (int n = 0; n < 2; ++n) _Pragma("unroll") for (int k = 0; k < 2; ++k) dst[n][k] = *(const PG8_LAS bf16x8*)(lds + PG8_SB(b, h) + boff + n * 2048 + k * 1024); } while (0)
#define PG8_MMA(ai, bj, At, Bt) do { __builtin_amdgcn_s_setprio(1); _Pragma("unroll") for (int m = 0; m < 4; ++m) _Pragma("unroll") for (int n = 0; n < 2; ++n) _Pragma("unroll") for (int k = 0; k < 2; ++k) \
        acc[ai][bj][m][n] = __builtin_amdgcn_mfma_f32_16x16x32_bf16(Bt[n][k], At[m][k], acc[ai][bj][m][n], 0, 0, 0); __builtin_amdgcn_s_setprio(0); } while (0)
#define PG8_WAIT_V(n) asm volatile("s_waitcnt vmcnt(" #n ")" ::: "memory")
#define PG8_WAIT_L(n) asm volatile("s_waitcnt lgkmcnt(" #n ")" ::: "memory")
#define PG8_BAR __builtin_amdgcn_s_barrier()
#define PG8_SCHED __builtin_amdgcn_sched_barrier(0)
    Unit cur, nxt; int ui = 0;
    if (!S.next(0, cur)) return;
    f32x4 acc[2][2][4][2];
#pragma unroll
    for (int a = 0; a < 2; ++a)
#pragma unroll
        for (int b = 0; b < 2; ++b)
#pragma unroll
            for (int m = 0; m < 4; ++m)
#pragma unroll
                for (int n = 0; n < 2; ++n) acc[a][b][m][n] = (f32x4){0.f, 0.f, 0.f, 0.f};
    bf16x8 At[4][2], B0[2][2], B1[2][2];
    const char* cA = (const char*)g.A + (size_t)cur.pm * tstep; const char* cB = (const char*)g.Bt + (size_t)cur.pn * tstep;
    S.a_ready(cur);
    if constexpr (SP2) {
        PG8_STAGE(PG8_SB(0, 0), cB, voffB); PG8_STAGE(PG8_SB(0, 1), cB + hstep, voffB); PG8_STAGE(PG8_SA(0, 0), cA, voffA); PG8_STAGE(PG8_SA(0, 1), cA + hstep, voffA);
        if (wr == 1) PG8_BAR;
        PG8_WAIT_V(2); PG8_BAR;
        PG8_STAGE(PG8_SB(1, 0), cB + kstep, voffB); PG8_STAGE(PG8_SA(1, 0), cA + kstep, voffA); PG8_STAGE(PG8_SB(1, 1), cB + hstep + kstep, voffB);
        PG8_WAIT_V(6); PG8_BAR;
    } else {
        PG8_STAGE(PG8_SB(0, 0), cB, voffB); PG8_STAGE(PG8_SA(0, 0), cA, voffA); PG8_STAGE(PG8_SB(0, 1), cB + hstep, voffB); PG8_STAGE(PG8_SA(0, 1), cA + hstep, voffA);
        if (wr == 1) PG8_BAR;
        PG8_WAIT_V(4); PG8_BAR;
        PG8_STAGE(PG8_SB(1, 0), cB + kstep, voffB); PG8_STAGE(PG8_SA(1, 0), cA + kstep, voffA); PG8_STAGE(PG8_SB(1, 1), cB + hstep + kstep, voffB);
        PG8_WAIT_V(6); PG8_BAR;
    }
    for (;;) {
        const bool has_next = S.next(ui + 1, nxt);
        const char* nA = has_next ? (const char*)g.A + (size_t)nxt.pm * tstep : cA; const char* nB = has_next ? (const char*)g.Bt + (size_t)nxt.pn * tstep : cB;
        for (int t = 0; t < nt; t += 2) {
            const bool last = (t == nt - 2);
            const char* a1 = cA + (size_t)(t + 1) * kstep;
            const char* a2 = last ? nA : cA + (size_t)(t + 2) * kstep; const char* b2 = last ? nB : cB + (size_t)(t + 2) * kstep;
            const char* a3 = a2 + kstep; const char* b3 = b2 + kstep;
            if (last && has_next) S.a_ready(nxt);
            if constexpr (SP2) {
            PG8_LDB(B0, 0, 0); PG8_LDB(B1, 0, 1); PG8_SCHED; PG8_LDA(At, 0, 0); PG8_STAGE(PG8_SA(1, 1), a1 + hstep, voffA);
            PG8_WAIT_V(8); PG8_WAIT_L(0); PG8_BAR; PG8_MMA(0, 0, At, B0); PG8_MMA(0, 1, At, B1); PG8_BAR; PG8_SCHED;
            PG8_LDA(At, 0, 1); PG8_STAGE(PG8_SB(0, 0), b2, voffB); PG8_STAGE(PG8_SB(0, 1), b2 + hstep, voffB); PG8_STAGE(PG8_SA(0, 0), a2, voffA);
            PG8_WAIT_V(8); PG8_WAIT_L(0); PG8_BAR; PG8_MMA(1, 0, At, B0); PG8_MMA(1, 1, At, B1); PG8_BAR; PG8_SCHED;
            PG8_LDB(B0, 1, 0); PG8_LDB(B1, 1, 1); PG8_SCHED; PG8_LDA(At, 1, 0); PG8_STAGE(PG8_SA(0, 1), a2 + hstep, voffA);
            PG8_WAIT_V(8); PG8_WAIT_L(0); PG8_BAR; PG8_MMA(0, 0, At, B0); PG8_MMA(0, 1, At, B1); PG8_BAR; PG8_SCHED;
            PG8_LDA(At, 1, 1); PG8_STAGE(PG8_SB(1, 0), b3, voffB); PG8_STAGE(PG8_SB(1, 1), b3 + hstep, voffB); PG8_STAGE(PG8_SA(1, 0), a3, voffA);
            PG8_WAIT_V(8); PG8_WAIT_L(0); PG8_BAR; PG8_MMA(1, 0, At, B0); PG8_MMA(1, 1, At, B1); PG8_BAR; PG8_SCHED;
            } else {
            PG8_LDB(B0, 0, 0); PG8_SCHED; PG8_LDA(At, 0, 0); PG8_STAGE(PG8_SA(1, 1), a1 + hstep, voffA);
            PG8_WAIT_L(8); PG8_BAR; PG8_WAIT_L(0); PG8_MMA(0, 0, At, B0); PG8_BAR; PG8_SCHED;
            PG8_LDB(B1, 0, 1); PG8_STAGE(PG8_SB(0, 0), b2, voffB);
            PG8_BAR; PG8_WAIT_L(0); PG8_MMA(0, 1, At, B1); PG8_BAR;
            PG8_LDA(At, 0, 1); PG8_STAGE(PG8_SA(0, 0), a2, voffA);
            PG8_BAR; PG8_WAIT_L(0); PG8_MMA(1, 0, At, B0); PG8_BAR; PG8_SCHED;
            PG8_STAGE(PG8_SB(0, 1), b2 + hstep, voffB);
            PG8_WAIT_V(6); PG8_BAR; PG8_MMA(1, 1, At, B1); PG8_BAR;
            PG8_LDB(B0, 1, 0); PG8_SCHED; PG8_LDA(At, 1, 0); PG8_STAGE(PG8_SA(0, 1), a2 + hstep, voffA);
            PG8_WAIT_L(8); PG8_BAR; PG8_WAIT_L(0); PG8_MMA(0, 0, At, B0); PG8_BAR; PG8_SCHED;
            PG8_LDB(B1, 1, 1); PG8_STAGE(PG8_SB(1, 0), b3, voffB);
            PG8_BAR; PG8_WAIT_L(0); PG8_MMA(0, 1, At, B1); PG8_BAR;
            PG8_LDA(At, 1, 1); PG8_STAGE(PG8_SA(1, 0), a3, voffA);
            PG8_BAR; PG8_WAIT_L(0); PG8_MMA(1, 0, At, B0); PG8_BAR; PG8_SCHED;
            PG8_STAGE(PG8_SB(1, 1), b3 + hstep, voffB);
            PG8_WAIT_V(6); PG8_BAR; PG8_MMA(1, 1, At, B1); PG8_BAR;
            }
        }
        if constexpr (ALIGN_EPI) { if (wr == 0) PG8_BAR; }
        if constexpr (!Epi::AFTER_DRAIN) { E(acc, cur, wr, wc, fr, fq); S.done(cur); }
        if (!has_next) break;
#pragma unroll
        for (int a = 0; a < 2; ++a)
#pragma unroll
            for (int b = 0; b < 2; ++b)
#pragma unroll
                for (int m = 0; m < 4; ++m)
#pragma unroll
                    for (int n = 0; n < 2; ++n) acc[a][b][m][n] = (f32x4){0.f, 0.f, 0.f, 0.f};
        cur = nxt; cA = nA; cB = nB; ++ui;
        if constexpr (ALIGN_EPI) { if (wr == 1) PG8_BAR; }
    }
    PG8_WAIT_V(0);
    if constexpr (!ALIGN_EPI) { if (wr == 0) PG8_BAR; }
    PG8_BAR;
    if constexpr (Epi::AFTER_DRAIN) { E.fused(acc, cur, wr, wc, fr, fq, lds, wid, lane); S.done(cur); }
#undef PG8_SA
#undef PG8_SB
#undef PG8_STAGE
#undef PG8_LDA
#undef PG8_LDB
#undef PG8_MMA
#undef PG8_WAIT_V
#undef PG8_WAIT_L
#undef PG8_BAR
#undef PG8_SCHED
}
}

#define DI __device__ __forceinline__
#define LAS __attribute__((address_space(3)))
using pg8::f32x4; using pg8::bf16_t; using pg8::bf16x8; using pg8::Unit;
typedef unsigned u32x2 __attribute__((ext_vector_type(2)));
typedef unsigned u32x4 __attribute__((ext_vector_type(4)));
typedef short s16x4 __attribute__((ext_vector_type(4)));
typedef float f32x16 __attribute__((ext_vector_type(16)));
typedef float f32x2_t __attribute__((ext_vector_type(2)));
typedef __bf16 bf16x2_t __attribute__((ext_vector_type(2)));
typedef LAS unsigned char* ldsp;

constexpr int MTOK = 16384, DM = 1024, SEQ = 8192, FF = 4096;
constexpr int WIN_COLS = 1952, WIN_PAD = 2048;
constexpr float EPS = 1e-6f;
constexpr float LOG2E = 1.4426950408889634f;
constexpr float QS_D = 0.125f * LOG2E;
constexpr float QS_M = 0.10206207261596575f * LOG2E;
#ifndef PH_MASK
#define PH_MASK 0xFFFF
#endif
constexpr int NTHREADS = 512;
constexpr int LDS_BYTES = 131072 + 2048;

constexpr size_t MiB = 1u << 20;
constexpr size_t WS_BAR = 1u << 20, WS_BAR_BYTES = 16384;
constexpr size_t WS_REFS = 240 * 1024;
constexpr size_t WS_MOD = 0, WS_BIAS1 = 98304, WS_BIAS2 = 131072, WS_GS1 = 196608, WS_GS2 = 212992;
constexpr size_t WS_W = 2 * MiB, WS_WSTRIDE = 23 * MiB;
constexpr size_t WO_IN = 0, WO_QU = 4 * MiB, WO_KV = 4 * MiB + 512 * 1024, WO_OUT = 5 * MiB, WO_W1 = 7 * MiB, WO_W2 = 15 * MiB;
constexpr size_t WS_XA = 48 * MiB;
constexpr size_t WS_QD = 80 * MiB, WS_KD = 96 * MiB, WS_VD = 112 * MiB, WS_QM = 128 * MiB, WS_KN = 152 * MiB, WS_VM = 168 * MiB, WS_OC = 184 * MiB;
constexpr size_t WS_KR = 216 * MiB, WS_CQ = 217 * MiB, WS_CKV = 225 * MiB, WS_PART = 217 * MiB, WS_LP = 249 * MiB;
constexpr size_t WS_SSQX = 250 * MiB, WS_SSQ2 = 251 * MiB, WS_SSQCQ = 252 * MiB, WS_SSQCKV = 252 * MiB + 256 * 1024;
constexpr size_t WS_H = 80 * MiB;
constexpr size_t WS_RCOS = 253 * MiB, WS_RSIN = 254 * MiB;
constexpr size_t WS_END = 255 * MiB;

__constant__ float c_inv[16] = {1.000000000e+00f, 5.623413324e-01f, 3.162277639e-01f, 1.778279394e-01f, 1.000000015e-01f, 5.623413250e-02f, 3.162277490e-02f, 1.778279431e-02f,
                                9.999999776e-03f, 5.623413250e-03f, 3.162277630e-03f, 1.778279431e-03f, 1.000000047e-03f, 5.623413017e-04f, 3.162277571e-04f, 1.778279402e-04f};

struct Params {
    const float* x; const float* c; const int* pos; const float* w_mod; const float* b_mod; const float* g_norm_mix; const float* w_in;
    const float* g_q_dil; const float* g_k_dil; const float* g_cq; const float* w_q_up; const float* g_ckv; const float* w_kv_up;
    const float* g_q_nope; const float* g_q_rope; const float* g_k_nope; const float* g_k_rope; const float* w_out; const float* g_norm_mlp;
    const float* w_mlp_in; const float* w_mlp_out; float* out; unsigned char* ws;
};

typedef __attribute__((address_space(4))) const char* c4ptr_t; typedef __attribute__((address_space(4))) const unsigned long long* c4u64_t;
#define GASP __attribute__((address_space(1)))
DI unsigned long long karg_u64(int off) { c4ptr_t kp = (c4ptr_t)__builtin_amdgcn_kernarg_segment_ptr(); asm volatile("" : "+s"(kp)); return *(c4u64_t)(kp + off); }
template <class T> DI T* gptr(unsigned long long v) { return (T*)(GASP T*)v; }
template <class P> struct pointee_of; template <class T> struct pointee_of<T*> { typedef T type; };
#define PF(name) (gptr<pointee_of<decltype(Params::name)>::type>(karg_u64((int)__builtin_offsetof(Params, name))))
DI int lane_id_v() { int l; asm volatile("v_mbcnt_lo_u32_b32 %0, -1, 0\n\tv_mbcnt_hi_u32_b32 %0, -1, %0" : "=v"(l)); return l; }
DI unsigned pk2(float lo, float hi) { f32x2_t v = {lo, hi}; bf16x2_t b = __builtin_convertvector(v, bf16x2_t); return __builtin_bit_cast(unsigned, b); }
DI u32x2 pack4(f32x4 v) { u32x2 w; w.x = pk2(v[0], v[1]); w.y = pk2(v[2], v[3]); return w; }
DI float sum4(f32x4 v) { return (v[0] + v[1]) + (v[2] + v[3]); }
DI float sq4(f32x4 v) { return (v[0] * v[0] + v[1] * v[1]) + (v[2] * v[2] + v[3] * v[3]); }
DI float xor16_sum(float v) { auto r = __builtin_amdgcn_permlane16_swap(__float_as_uint(v), __float_as_uint(v), false, false); return __uint_as_float(r[0]) + __uint_as_float(r[1]); }
DI float xor32_sum(float v) { auto r = __builtin_amdgcn_permlane32_swap(__float_as_uint(v), __float_as_uint(v), false, false); return __uint_as_float(r[0]) + __uint_as_float(r[1]); }
template <int K> DI float swz_xor(float v) { return __uint_as_float((unsigned)__builtin_amdgcn_ds_swizzle((int)__float_as_uint(v), (K << 10) | 0x1f)); }
DI float red_fq(float s) { return xor32_sum(xor16_sum(s)); }
DI float wave_sum(float v) { v += swz_xor<1>(v); v += swz_xor<2>(v); v += swz_xor<4>(v); v += swz_xor<8>(v); return xor32_sum(xor16_sum(v)); }
DI float umax_abs(const float* g, int n) { float r = 0.f; for (int i = 0; i < n; ++i) r = fmaxf(r, fabsf(g[i])); return r; }
DI float fadd_s(float a, float b) { float r; asm("v_add_f32_e32 %0, %1, %2" : "=v"(r) : "v"(a), "v"(b)); return r; }
DI float rsq(float v) { return __builtin_amdgcn_rsqf(v); }
DI float bf2f(unsigned short u) { return __uint_as_float(((unsigned)u) << 16); }
DI void sincos_rev(float ang, float& s, float& c) {
    const double rev = (double)ang * 0.15915494309189535;
    const float f = (float)(rev - __builtin_rint(rev));
    s = __builtin_amdgcn_sinf(f); c = __builtin_amdgcn_cosf(f);
}

#define GAS __attribute__((address_space(1)))
#define XB_TMO      128
#define XB_XCNT(j)  (256  + 64 * (j))
#define XB_XSUB(j)  (1280 + 64 * (j))
#define XB_XGEN(j)  (2304 + 64 * (j))
#define XB_TOP      3328
#define XB_TOPGEN   3392
#define XCD_BAR_WORDS 3456
#define XB_SPIN_CAP (1u << 18)

__device__ __forceinline__ unsigned xb_ld(unsigned* p)              { return __hip_atomic_load(p, __ATOMIC_RELAXED, __HIP_MEMORY_SCOPE_AGENT); }
__device__ __forceinline__ unsigned xb_add(unsigned* p, unsigned v) { return __hip_atomic_fetch_add(p, v, __ATOMIC_RELAXED, __HIP_MEMORY_SCOPE_AGENT); }
__device__ __forceinline__ unsigned xb_xcc_id() { return (unsigned)__builtin_amdgcn_s_getreg((3 << 11) | 20) & 0xFu; }
#define XB_SPIN(cond, bar) do { unsigned _sp = 0; while (cond) { __builtin_amdgcn_s_sleep(1); \
    if ((++_sp & 255u) == 0u) { if (xb_ld(&(bar)[XB_TMO])) break; if (_sp > XB_SPIN_CAP) { atomicAdd(&(bar)[XB_TMO], 1u); break; } } } } while (0)

struct XcdBarrier {
    unsigned* bar; unsigned x;
    volatile LAS unsigned* st;
};

__device__ __forceinline__ XcdBarrier xcd_barrier_post(unsigned* bar, volatile LAS unsigned* st, const int tid) {
    XcdBarrier b; b.bar = bar; b.x = xb_xcc_id(); b.st = st;
    if (tid == 0) (void)xb_add(&bar[XB_XCNT(b.x)], 1u);
    return b;
}
__device__ __forceinline__ void xcd_barrier_complete(unsigned* bar, unsigned x, unsigned& nloc, unsigned& nx) {
    const unsigned G = gridDim.x * gridDim.y * gridDim.z;
    unsigned sum, cnt, mine, sp = 0u;
    for (;;) {
        sum = 0u; cnt = 0u; mine = 0u;
#pragma unroll
        for (unsigned j = 0; j < 16; ++j) { const unsigned c = xb_ld(&bar[XB_XCNT(j)]); sum += c; cnt += (c > 0u) ? 1u : 0u; mine = (j == x) ? c : mine; }
        if (sum == G) break;
        __builtin_amdgcn_s_sleep(1);
        if ((++sp & 255u) == 0u) { if (xb_ld(&bar[XB_TMO])) break; if (sp > XB_SPIN_CAP) { atomicAdd(&bar[XB_TMO], 1u); break; } }
    }
    nloc = mine > 0u ? mine : 1u; nx = cnt > 0u ? cnt : 1u;
}

__device__ __forceinline__ void xcd_barrier(const XcdBarrier& b, const int tid) {
    asm volatile("s_waitcnt vmcnt(0)" ::: "memory");
    __syncthreads();
    if (tid == 0) {
        unsigned* bar = b.bar;
        __builtin_amdgcn_s_waitcnt(0);
        unsigned nloc = b.st[0], nx = b.st[1];
        if (nloc == 0u) { xcd_barrier_complete(bar, b.x, nloc, nx); b.st[0] = nloc; b.st[1] = nx; }
        const unsigned old = xb_add(&bar[XB_XSUB(b.x)], 1u);
        const unsigned gen = old / nloc;
        if (old + 1u == (gen + 1u) * nloc) {
            __builtin_amdgcn_fence(__ATOMIC_RELEASE, "agent");
            asm volatile("s_waitcnt vmcnt(0)" ::: "memory");
            const unsigned og = xb_add(&bar[XB_TOP], 1u);
            const unsigned tg = og / nx;
            if (og + 1u == (tg + 1u) * nx) xb_add(&bar[XB_TOPGEN], 1u);
            else XB_SPIN(xb_ld(&bar[XB_TOPGEN]) == tg, bar);
            __builtin_amdgcn_fence(__ATOMIC_ACQUIRE, "agent");
            xb_add(&bar[XB_XGEN(b.x)], 1u);
            asm volatile("s_waitcnt vmcnt(0)" ::: "memory");
        } else {
            XB_SPIN(xb_ld(&bar[XB_XGEN(b.x)]) == gen, bar);
            __builtin_amdgcn_fence(__ATOMIC_ACQUIRE, "agent");
            asm volatile("s_waitcnt vmcnt(0)" ::: "memory");
        }
    }
    __syncthreads();
}


#define EPI_FENCE() asm volatile("" ::: "memory")
struct EpiIn {
    static constexpr bool PERM = true, AFTER_DRAIN = false;
    unsigned char* wsb; const float* bias; const float* gq; const float* gk; const float* gkr;
    DI void operator()(const f32x4 (&acc)[2][2][4][2], const Unit& u, int wr, int wc, int fr, int fq) const {
        const float* ssq = (const float*)(wsb + WS_SSQX); const float* rcos = (const float*)(wsb + WS_RCOS); const float* rsin = (const float*)(wsb + WS_RSIN);
        bf16_t* Qd = (bf16_t*)(wsb + WS_QD); bf16_t* Kd = (bf16_t*)(wsb + WS_KD); bf16_t* Vd = (bf16_t*)(wsb + WS_VD);
        bf16_t* CQ = (bf16_t*)(wsb + WS_CQ); bf16_t* CKV = (bf16_t*)(wsb + WS_CKV); bf16_t* Kr = (bf16_t*)(wsb + WS_KR);
        float* ssq_cq = (float*)(wsb + WS_SSQCQ); float* ssq_ckv = (float*)(wsb + WS_SSQCKV);
        const int b = u.pm >> 5, pn = u.pn, lc0 = 64 * wc + 8 * fq;
        const float* bp = bias + b * WIN_PAD + 256 * pn + lc0;
        f32x4 bv[2][2], gv[2][2];
#pragma unroll
        for (int bj = 0; bj < 2; ++bj)
#pragma unroll
            for (int n = 0; n < 2; ++n) { bv[bj][n] = *(const f32x4*)(bp + 32 * bj + 4 * n); gv[bj][n] = (f32x4){1.f, 1.f, 1.f, 1.f}; }
        if (pn < 4) { const float* g = (pn < 2 ? gq : gk) + 8 * fq;
#pragma unroll
            for (int bj = 0; bj < 2; ++bj)
#pragma unroll
                for (int n = 0; n < 2; ++n) gv[bj][n] = *(const f32x4*)(g + 32 * bj + 4 * n);
        } else if (pn == 7) { gv[0][0] = *(const f32x4*)(gkr + 8 * fq); gv[0][1] = *(const f32x4*)(gkr + 8 * fq + 4); }
        float rstdv[2][4];
#pragma unroll
        for (int ai = 0; ai < 2; ++ai)
#pragma unroll
            for (int m = 0; m < 4; ++m) { const int row = u.pm * 256 + ai * 128 + wr * 64 + m * 16 + fr;
                rstdv[ai][m] = rsq(red_fq(sum4(*(const f32x4*)(ssq + (size_t)row * 16 + 4 * fq))) * (1.f / 1024.f) + EPS); }
#define EPI_ST16(dst_, v0_, v1_) do { u32x4 w_; w_.x = pk2((v0_)[0], (v0_)[1]); w_.y = pk2((v0_)[2], (v0_)[3]); w_.z = pk2((v1_)[0], (v1_)[1]); w_.w = pk2((v1_)[2], (v1_)[3]); *(u32x4*)(dst_) = w_; } while (0)
#pragma unroll
        for (int ai = 0; ai < 2; ++ai)
#pragma unroll
            for (int m = 0; m < 4; ++m) {
                const int row = u.pm * 256 + ai * 128 + wr * 64 + m * 16 + fr;
                const float rstd = rstdv[ai][m];
                f32x4 z[2][2]; float ss = 0.f;
#pragma unroll
                for (int bj = 0; bj < 2; ++bj)
#pragma unroll
                    for (int n = 0; n < 2; ++n) { z[bj][n] = acc[ai][bj][m][n] * rstd + bv[bj][n]; ss += sq4(z[bj][n]); }
                if (pn < 4) {
                    ss = red_fq(ss);
                    const float r = rsq(ss * (1.f / 64.f) + EPS) * (pn < 2 ? QS_D : 1.f);
                    bf16_t* dst = (pn < 2 ? Qd : Kd) + (size_t)row * 512 + (pn & 1) * 256 + lc0;
#pragma unroll
                    for (int bj = 0; bj < 2; ++bj) EPI_ST16(dst + 32 * bj, z[bj][0] * r * gv[bj][0], z[bj][1] * r * gv[bj][1]);
                } else if (pn < 6) {
                    bf16_t* dst = Vd + (size_t)row * 512 + (pn - 4) * 256 + lc0;
#pragma unroll
                    for (int bj = 0; bj < 2; ++bj) EPI_ST16(dst + 32 * bj, z[bj][0], z[bj][1]);
                } else if (pn == 6) {
                    ss = red_fq(ss);
                    bf16_t* dst = CQ + (size_t)row * 256 + lc0;
#pragma unroll
                    for (int bj = 0; bj < 2; ++bj) EPI_ST16(dst + 32 * bj, z[bj][0], z[bj][1]);
                    if (fq == 0) ssq_cq[(size_t)row * 4 + wc] = ss;
                } else {
                    if (wc < 2) {
                        ss = red_fq(ss);
                        bf16_t* dst = CKV + (size_t)row * 128 + lc0;
#pragma unroll
                        for (int bj = 0; bj < 2; ++bj) EPI_ST16(dst + 32 * bj, z[bj][0], z[bj][1]);
                        if (fq == 0) ssq_ckv[(size_t)row * 2 + wc] = ss;
                    } else if (wc == 2) {
                        const float s8 = red_fq(sq4(z[0][0]) + sq4(z[0][1]));
                        const float r = rsq(s8 * (1.f / 32.f) + EPS);
                        const float sg = fq < 2 ? -1.f : 1.f;
                        f32x4 o0, o1;
#pragma unroll
                        for (int n = 0; n < 2; ++n) {
                            const f32x4 y = z[0][n] * r * gv[0][n];
                            const f32x4 cv = *(const f32x4*)(rcos + (size_t)row * 16 + 8 * (fq & 1) + 4 * n), sv = *(const f32x4*)(rsin + (size_t)row * 16 + 8 * (fq & 1) + 4 * n);
                            f32x4 o;
#pragma unroll
                            for (int e = 0; e < 4; ++e) {
                                auto sw = __builtin_amdgcn_permlane32_swap(__float_as_uint(y[e]), __float_as_uint(y[e]), false, false);
                                const float p = __uint_as_float(fq < 2 ? sw[1] : sw[0]);
                                o[e] = y[e] * cv[e] + p * sv[e] * sg; }
                            if (n == 0) o0 = o; else o1 = o;
                        }
                        EPI_ST16(Kr + (size_t)row * 32 + 8 * fq, o0, o1);
                    }
                }
                EPI_FENCE();
            }
#undef EPI_ST16
    }
};

struct EpiQup {
    static constexpr bool PERM = true, AFTER_DRAIN = false;
    const float* ssq_cq; const float* gqn; const float* gqr; const float* rcos; const float* rsin; bf16_t* Qm;
    DI void operator()(const f32x4 (&acc)[2][2][4][2], const Unit& u, int wr, int wc, int fr, int fq) const {
        const int pn = u.pn;
        float rstdv[2][4];
#pragma unroll
        for (int ai = 0; ai < 2; ++ai)
#pragma unroll
            for (int m = 0; m < 4; ++m) { const int row = u.pm * 256 + ai * 128 + wr * 64 + m * 16 + fr;
                rstdv[ai][m] = rsq(sum4(*(const f32x4*)(ssq_cq + (size_t)row * 4)) * (1.f / 256.f) + EPS); }
#pragma unroll
        for (int ai = 0; ai < 2; ++ai)
#pragma unroll
            for (int m = 0; m < 4; ++m) {
                const int row = u.pm * 256 + ai * 128 + wr * 64 + m * 16 + fr;
                const float rstd = rstdv[ai][m];
                f32x4 z[2][2];
#pragma unroll
                for (int bj = 0; bj < 2; ++bj)
#pragma unroll
                    for (int n = 0; n < 2; ++n) z[bj][n] = acc[ai][bj][m][n] * rstd;
                if (pn < 2) {
                    float ss = (sq4(z[0][0]) + sq4(z[0][1])) + (sq4(z[1][0]) + sq4(z[1][1]));
                    ss = red_fq(ss);
                    const float r = rsq(ss * (1.f / 64.f) + EPS) * QS_M;
                    bf16_t* dst = Qm + (size_t)row * 768 + (4 * pn + wc) * 96 + 8 * fq;
#pragma unroll
                    for (int bj = 0; bj < 2; ++bj) { const f32x4 y0 = z[bj][0] * r * *(const f32x4*)(gqn + 8 * fq + 32 * bj), y1 = z[bj][1] * r * *(const f32x4*)(gqn + 8 * fq + 32 * bj + 4);
                        u32x4 w; w.x = pk2(y0[0], y0[1]); w.y = pk2(y0[2], y0[3]); w.z = pk2(y1[0], y1[1]); w.w = pk2(y1[2], y1[3]); *(u32x4*)(dst + 32 * bj) = w; }
                } else {
                    const float sg = fq < 2 ? -1.f : 1.f;
#pragma unroll
                    for (int bj = 0; bj < 2; ++bj) {
                        const float s8 = red_fq(sq4(z[bj][0]) + sq4(z[bj][1]));
                        const float r = rsq(s8 * (1.f / 32.f) + EPS) * QS_M;
                        f32x4 o0, o1;
#pragma unroll
                        for (int n = 0; n < 2; ++n) {
                            const f32x4 y = z[bj][n] * r * *(const f32x4*)(gqr + 8 * fq + 4 * n);
                            const f32x4 cv = *(const f32x4*)(rcos + (size_t)row * 16 + 8 * (fq & 1) + 4 * n), sv = *(const f32x4*)(rsin + (size_t)row * 16 + 8 * (fq & 1) + 4 * n);
                            f32x4 o;
#pragma unroll
                            for (int e = 0; e < 4; ++e) {
                                auto sw = __builtin_amdgcn_permlane32_swap(__float_as_uint(y[e]), __float_as_uint(y[e]), false, false);
                                const float p = __uint_as_float(fq < 2 ? sw[1] : sw[0]);
                                o[e] = y[e] * cv[e] + p * sv[e] * sg; }
                            if (n == 0) o0 = o; else o1 = o;
                        }
                        bf16_t* dst = Qm + (size_t)row * 768 + (2 * wc + bj) * 96 + 64 + 8 * fq;
                        u32x4 w; w.x = pk2(o0[0], o0[1]); w.y = pk2(o0[2], o0[3]); w.z = pk2(o1[0], o1[1]); w.w = pk2(o1[2], o1[3]); *(u32x4*)dst = w;
                    }
                }
            }
    }
};

struct EpiKvup {
    static constexpr bool PERM = true, AFTER_DRAIN = false;
    const float* ssq_ckv; const float* gkn; bf16_t* Kn; bf16_t* Vm;
    DI void operator()(const f32x4 (&acc)[2][2][4][2], const Unit& u, int wr, int wc, int fr, int fq) const {
        const int pn = u.pn;
        float rstdv[2][4];
#pragma unroll
        for (int ai = 0; ai < 2; ++ai)
#pragma unroll
            for (int m = 0; m < 4; ++m) { const int row = u.pm * 256 + ai * 128 + wr * 64 + m * 16 + fr;
                const f32x2_t sp = *(const f32x2_t*)(ssq_ckv + (size_t)row * 2); rstdv[ai][m] = rsq((sp[0] + sp[1]) * (1.f / 128.f) + EPS); }
#pragma unroll
        for (int ai = 0; ai < 2; ++ai)
#pragma unroll
            for (int m = 0; m < 4; ++m) {
                const int row = u.pm * 256 + ai * 128 + wr * 64 + m * 16 + fr;
                const float rstd = rstdv[ai][m];
                f32x4 z[2][2];
#pragma unroll
                for (int bj = 0; bj < 2; ++bj)
#pragma unroll
                    for (int n = 0; n < 2; ++n) z[bj][n] = acc[ai][bj][m][n] * rstd;
                if (pn < 2) {
                    float ss = (sq4(z[0][0]) + sq4(z[0][1])) + (sq4(z[1][0]) + sq4(z[1][1]));
                    ss = red_fq(ss);
                    const float r = rsq(ss * (1.f / 64.f) + EPS);
                    bf16_t* dst = Kn + (size_t)row * 512 + (4 * pn + wc) * 64 + 8 * fq;
#pragma unroll
                    for (int bj = 0; bj < 2; ++bj) { const f32x4 y0 = z[bj][0] * r * *(const f32x4*)(gkn + 8 * fq + 32 * bj), y1 = z[bj][1] * r * *(const f32x4*)(gkn + 8 * fq + 32 * bj + 4);
                        u32x4 w; w.x = pk2(y0[0], y0[1]); w.y = pk2(y0[2], y0[3]); w.z = pk2(y1[0], y1[1]); w.w = pk2(y1[2], y1[3]); *(u32x4*)(dst + 32 * bj) = w; }
                } else {
                    bf16_t* dst = Vm + (size_t)row * 512 + (4 * (pn - 2) + wc) * 64 + 8 * fq;
#pragma unroll
                    for (int bj = 0; bj < 2; ++bj) { u32x4 w; w.x = pk2(z[bj][0][0], z[bj][0][1]); w.y = pk2(z[bj][0][2], z[bj][0][3]); w.z = pk2(z[bj][1][0], z[bj][1][1]); w.w = pk2(z[bj][1][2], z[bj][1][3]);
                        *(u32x4*)(dst + 32 * bj) = w; }
                }
            }
    }
};

struct EpiRes {
    static constexpr bool PERM = true, AFTER_DRAIN = false;
    const float* xin; float* out; const float* gate; const float* gs; bf16_t* XA; float* ssq;
    DI void operator()(const f32x4 (&acc)[2][2][4][2], const Unit& u, int wr, int wc, int fr, int fq) const {
        const int b = u.pm >> 5, c0 = u.pn * 256 + wc * 32 + 8 * fq;
        f32x4 gt[2][2], gsv[2][2];
#pragma unroll
        for (int bj = 0; bj < 2; ++bj)
#pragma unroll
            for (int n = 0; n < 2; ++n) { gt[bj][n] = *(const f32x4*)(gate + b * 6144 + c0 + 128 * bj + 4 * n);
                gsv[bj][n] = gs ? *(const f32x4*)(gs + b * DM + c0 + 128 * bj + 4 * n) : (f32x4){0.f, 0.f, 0.f, 0.f}; }
        f32x4 xc[2][2], xn[2][2];
#pragma unroll
        for (int bj = 0; bj < 2; ++bj)
#pragma unroll
            for (int n = 0; n < 2; ++n) xc[bj][n] = *(const f32x4*)(xin + (size_t)(u.pm * 256 + wr * 64 + fr) * DM + c0 + 128 * bj + 4 * n);
#pragma unroll
        for (int rg = 0; rg < 8; ++rg) {
            const int ai = rg >> 2, m = rg & 3;
            const int row = u.pm * 256 + ai * 128 + wr * 64 + m * 16 + fr;
            const size_t off = (size_t)row * DM + c0;
            if (rg < 7) { const int ai2 = (rg + 1) >> 2, m2 = (rg + 1) & 3; const size_t off2 = (size_t)(u.pm * 256 + ai2 * 128 + wr * 64 + m2 * 16 + fr) * DM + c0;
#pragma unroll
                for (int bj = 0; bj < 2; ++bj)
#pragma unroll
                    for (int n = 0; n < 2; ++n) xn[bj][n] = *(const f32x4*)(xin + off2 + 128 * bj + 4 * n); }
            float ss = 0.f;
#pragma unroll
            for (int bj = 0; bj < 2; ++bj) {
                const f32x4 xo0 = xc[bj][0] + gt[bj][0] * acc[ai][bj][m][0], xo1 = xc[bj][1] + gt[bj][1] * acc[ai][bj][m][1];
                *(f32x4*)(out + off + 128 * bj) = xo0; *(f32x4*)(out + off + 128 * bj + 4) = xo1;
                if (gs) { ss += sq4(xo0) + sq4(xo1); const f32x4 y0 = xo0 * gsv[bj][0], y1 = xo1 * gsv[bj][1];
                    u32x4 w; w.x = pk2(y0[0], y0[1]); w.y = pk2(y0[2], y0[3]); w.z = pk2(y1[0], y1[1]); w.w = pk2(y1[2], y1[3]);
                    *(u32x4*)(XA + off + 128 * bj) = w; }
            }
            if (gs) { ss = red_fq(ss); if (fq == 0) ssq[(size_t)row * 16 + 4 * u.pn + wc] = ss; }
#pragma unroll
            for (int bj = 0; bj < 2; ++bj)
#pragma unroll
                for (int n = 0; n < 2; ++n) xc[bj][n] = xn[bj][n];
        }
    }
};

struct EpiUp {
    static constexpr bool PERM = true, AFTER_DRAIN = false;
    const float* ssq; const float* bias; bf16_t* H;
    DI void operator()(const f32x4 (&acc)[2][2][4][2], const Unit& u, int wr, int wc, int fr, int fq) const {
        const int b = u.pm >> 5, c0 = u.pn * 256 + wc * 32 + 8 * fq;
        f32x4 bv[2][2];
#pragma unroll
        for (int bj = 0; bj < 2; ++bj)
#pragma unroll
            for (int n = 0; n < 2; ++n) bv[bj][n] = *(const f32x4*)(bias + b * FF + c0 + 128 * bj + 4 * n);
        float rstdv[2][4];
#pragma unroll
        for (int ai = 0; ai < 2; ++ai)
#pragma unroll
            for (int m = 0; m < 4; ++m) { const int row = u.pm * 256 + ai * 128 + wr * 64 + m * 16 + fr;
                rstdv[ai][m] = rsq(red_fq(sum4(*(const f32x4*)(ssq + (size_t)row * 16 + 4 * fq))) * (1.f / 1024.f) + EPS); }
#pragma unroll
        for (int ai = 0; ai < 2; ++ai)
#pragma unroll
            for (int m = 0; m < 4; ++m) {
                const int row = u.pm * 256 + ai * 128 + wr * 64 + m * 16 + fr;
                const float rstd = rstdv[ai][m];
                bf16_t* dst = H + (size_t)row * FF + c0;
#pragma unroll
                for (int bj = 0; bj < 2; ++bj) {
                    f32x4 z0 = acc[ai][bj][m][0] * rstd + bv[bj][0], z1 = acc[ai][bj][m][1] * rstd + bv[bj][1];
#pragma unroll
                    for (int e = 0; e < 4; ++e) { const float t0 = fmaxf(z0[e], 0.f), t1 = fmaxf(z1[e], 0.f); z0[e] = t0 * t0; z1[e] = t1 * t1; }
                    u32x4 w; w.x = pk2(z0[0], z0[1]); w.y = pk2(z0[2], z0[3]); w.z = pk2(z1[0], z1[1]); w.w = pk2(z1[2], z1[3]);
                    *(u32x4*)(dst + 128 * bj) = w;
                }
            }
    }
};

template <class LB>
DI void transpose_item(const float* W, int K, int N, int NpG  , bf16_t* WT, const float* gk, LAS float* scr, int item, int lane, LB lbase) {
    const int kb = item / NpG, G = item % NpG, k0 = 64 * kb;
    const int lb = lbase(G);
#pragma unroll
    for (int i = 0; i < 8; ++i) { const int kk = 8 * i + (lane >> 3), c4 = lane & 7;
        f32x4 v = (f32x4){0.f, 0.f, 0.f, 0.f};
        if (lb >= 0) { v = *(const f32x4*)(W + (size_t)(k0 + kk) * N + lb + 4 * c4); if (gk) v = v * gk[k0 + kk]; }
        LAS float* d = scr + kk * 33 + 4 * c4; d[0] = v[0]; d[1] = v[1]; d[2] = v[2]; d[3] = v[3]; }
    asm volatile("s_waitcnt lgkmcnt(0)" ::: "memory");
    const int c = lane & 7;
#pragma unroll
    for (int j = 0; j < 4; ++j) { const int n = (lane >> 3) + 8 * j; const LAS float* s = scr + (8 * c) * 33 + n;
        u32x4 o; o.x = pk2(s[0 * 33], s[1 * 33]); o.y = pk2(s[2 * 33], s[3 * 33]); o.z = pk2(s[4 * 33], s[5 * 33]); o.w = pk2(s[6 * 33], s[7 * 33]);
        *(u32x4*)(WT + (size_t)(32 * G + n) * K + k0 + 8 * c) = o; }
    asm volatile("s_waitcnt lgkmcnt(0)" ::: "memory");
}

DI void gemv_unit(const float* W, int N, int Nout, int nb, const LAS float* vecs, LAS float* red, float* out0, float* out1, const float* addend, int tid) {
    const int wid = tid >> 6, lane = tid & 63, n = nb * 64 + lane; const bool ok = n < N;
    float a0 = 0.f, a1 = 0.f;
    const float* wp = W + (size_t)(wid * 128) * N + (ok ? n : 0);
#pragma unroll 32
    for (int k = 0; k < 128; ++k) { const float w = ok ? wp[(size_t)k * N] : 0.f; a0 += vecs[wid * 128 + k] * w; a1 += vecs[1024 + wid * 128 + k] * w; }
    red[(wid * 2 + 0) * 64 + lane] = a0; red[(wid * 2 + 1) * 64 + lane] = a1;
    __syncthreads();
    if (tid < 128) { const int bb = tid >> 6, ln = tid & 63; float s = 0.f;
#pragma unroll
        for (int w = 0; w < 8; ++w) s += red[(w * 2 + bb) * 64 + ln];
        const int nn = nb * 64 + ln; if (nn < Nout) (bb ? out1 : out0)[nn] = s + ((addend && nn < N) ? addend[nn] : 0.f); }
    __syncthreads();
}

#define MFMA32(a, b, c) __builtin_amdgcn_mfma_f32_32x32x16_bf16((a), (b), (c), 0, 0, 0)
DI int crow(int r, int hi) { return (r & 3) + 8 * (r >> 2) + 4 * hi; }
DI bf16x8 pack8(const f32x16& p, int s) { u32x4 w; w.x = pk2(p[8 * s + 0], p[8 * s + 1]); w.y = pk2(p[8 * s + 2], p[8 * s + 3]); w.z = pk2(p[8 * s + 4], p[8 * s + 5]); w.w = pk2(p[8 * s + 6], p[8 * s + 7]); return __builtin_bit_cast(bf16x8, w); }
typedef short v4i16_t __attribute__((ext_vector_type(4)));
DI bf16x8 vfrag_tr(const LAS unsigned char* p, int second) { const s16x4 lo = __builtin_bit_cast(s16x4, __builtin_amdgcn_ds_read_tr16_b64_v4i16((LAS v4i16_t*)p)), hi = __builtin_bit_cast(s16x4, __builtin_amdgcn_ds_read_tr16_b64_v4i16((LAS v4i16_t*)(p + second))); return (bf16x8){lo[0], lo[1], lo[2], lo[3], hi[0], hi[1], hi[2], hi[3]}; }
DI bf16x8 vfrag(const LAS unsigned char* p) { const s16x4 lo = *(const LAS s16x4*)p, hi = *(const LAS s16x4*)(p + 16); return (bf16x8){lo[0], lo[1], lo[2], lo[3], hi[0], hi[1], hi[2], hi[3]}; }

constexpr int KSTR = 208, VSTR = 136, KBUF = 64 * KSTR, VBUF = 64 * VSTR;
#define SBAR() __builtin_amdgcn_sched_barrier(0)
DI void mla_unit(ldsp lds, int b, int h, int qb, const bf16_t* Qm_, const bf16_t* Kn_, const bf16_t* Kr_, const bf16_t* Vm_, bf16_t* OC_, float ref, const int wid) {
    int lane = lane_id_v(); asm volatile("" : "+v"(lane));
    const int tid = wid * 64 + lane, q = lane & 31, hi = lane >> 5;
    constexpr int NT = SEQ / 64;
    constexpr int VR = 192, VBUF2 = 64 * VR;
    const int rot = (qb * 4) & (NT - 1);
    const size_t tokb = (size_t)b * SEQ;
    bf16x8 qf[6];
    { const size_t tq = tokb + qb * 256 + wid * 32 + q;
#pragma unroll
    for (int d0 = 0; d0 < 6; ++d0) qf[d0] = *(const bf16x8*)(Qm_ + tq * 768 + h * 96 + d0 * 16 + hi * 8); }
    f32x16 o0, o1, negref;
#pragma unroll
    for (int r = 0; r < 16; ++r) { o0[r] = 0.f; o1[r] = 0.f; negref[r] = 0.f; }
    float lsA = 0.f, lsB = 0.f;
    const int s_row = tid >> 3, s_part = tid & 7, r_row = (tid >> 2) & 63, r_part = tid & 3;
    const char* kn_base = (const char*)(Kn_ + tokb * 512 + h * 64);
    const char* kr_base = (const char*)(Kr_ + tokb * 32);
    const char* v_base = (const char*)(Vm_ + tokb * 512 + h * 64);
    const unsigned kn_vo = (unsigned)(s_row * 512 + s_part * 8) * 2u, kr_vo = (unsigned)(r_row * 32 + r_part * 8) * 2u, v_vo = kn_vo;
    const ldsp Kl = lds, Vl = lds + 4 * KBUF;
    const int vtb = (4 * hi + ((lane & 15) >> 2)) * VR + (16 * ((lane >> 4) & 1) + 4 * (lane & 3)) * 2;
    u32x4 rk, rv, rr = (u32x4){0u, 0u, 0u, 0u};
#define MLA_LDK(t_) do { const unsigned tt_ = (unsigned)((t_) + rot) & (NT - 1); unsigned long long pk_ = (unsigned long long)(kn_base + (size_t)tt_ * (64 * 512 * 2)), pr_ = (unsigned long long)(kr_base + (size_t)tt_ * (64 * 32 * 2)); \
        asm volatile("" : "+s"(pk_), "+s"(pr_)); rk = *(const u32x4*)(gptr<const char>(pk_) + kn_vo); rr = *(const u32x4*)(gptr<const char>(pr_) + kr_vo); } while (0)
#define MLA_LDV(t_) do { const unsigned tt_ = (unsigned)((t_) + rot) & (NT - 1); unsigned long long pv_ = (unsigned long long)(v_base + (size_t)tt_ * (64 * 512 * 2)); asm volatile("" : "+s"(pv_)); rv = *(const u32x4*)(gptr<const char>(pv_) + v_vo); } while (0)
#define MLA_STK(buf) do { *(LAS u32x4*)(Kl + (buf) * KBUF + s_row * KSTR + s_part * 16) = rk; \
        *(LAS u32x4*)(Kl + (buf) * KBUF + r_row * KSTR + 128 + r_part * 16) = rr; } while (0)
#define MLA_STV(buf) do { *(LAS u32x4*)(Vl + (buf) * VBUF2 + s_row * VR + s_part * 16) = rv; } while (0)
    {
        u32x4 k0_, r0_, k1_, r1_, k2_, r2_, v0_;
        MLA_LDK(0); k0_ = rk; r0_ = rr; MLA_LDK(1); k1_ = rk; r1_ = rr; MLA_LDK(2); k2_ = rk; r2_ = rr; MLA_LDV(0); v0_ = rv;
        rk = k0_; rr = r0_; MLA_STK(0); rk = k1_; rr = r1_; MLA_STK(1); rk = k2_; rr = r2_; MLA_STK(2); rv = v0_; MLA_STV(0);
    }
    for (int i = tid; i < VBUF2 / 4; i += NTHREADS) ((LAS unsigned*)(Vl + 3 * VBUF2))[i] = 0u;
    MLA_LDK(3); MLA_LDV(1);
    __syncthreads();
    f32x16 cA0 = negref, cA1 = negref, cB0, cB1;
    {
        const ldsp kb = Kl + q * KSTR + hi * 16;
#pragma unroll
        for (int d0 = 0; d0 < 6; ++d0) { cA0 = MFMA32(*(const LAS bf16x8*)(kb + d0 * 32), qf[d0], cA0); cA1 = MFMA32(*(const LAS bf16x8*)(kb + 32 * KSTR + d0 * 32), qf[d0], cA1); SBAR(); }
    }
    __syncthreads();
    u32x4 ppA[4];
#pragma unroll
    for (int k = 0; k < 4; ++k) ppA[k] = (u32x4){0u, 0u, 0u, 0u};
#define MLA_LOADF(g) do { if ((g) < 8) fr[(g) % 3] = vfrag_tr(vbp + ((g) & 1) * 64 + ((g) >> 1) * 16 * VR, 8 * VR); \
                          else fr[(g) % 3] = *(const LAS bf16x8*)(kbn + ((g) & 1) * 32 * KSTR + (((g) - 8) >> 1) * 32); } while (0)
#define MLA_GAP(g, c0, c1, n0, n1, pp, pc) do { \
        if ((g) < 8) { if ((g) & 1) o1 = MFMA32(fr[(g) % 3], __builtin_bit_cast(bf16x8, pp[(g) >> 1]), o1); else o0 = MFMA32(fr[(g) % 3], __builtin_bit_cast(bf16x8, pp[(g) >> 1]), o0); } \
        else if ((g) < 10) { if ((g) & 1) n1 = MFMA32(fr[(g) % 3], qf[0], ((f32x16){0.f,0.f,0.f,0.f,0.f,0.f,0.f,0.f,0.f,0.f,0.f,0.f,0.f,0.f,0.f,0.f})); else n0 = MFMA32(fr[(g) % 3], qf[0], ((f32x16){0.f,0.f,0.f,0.f,0.f,0.f,0.f,0.f,0.f,0.f,0.f,0.f,0.f,0.f,0.f,0.f})); } \
        else { if ((g) & 1) n1 = MFMA32(fr[(g) % 3], qf[((g) - 8) >> 1], n1); else n0 = MFMA32(fr[(g) % 3], qf[((g) - 8) >> 1], n0); } \
        if ((g) + 2 < 20) MLA_LOADF((g) + 2); \
        if ((g) >= 4 && (g) < 12) { c0[2 * ((g) - 4)] = __builtin_amdgcn_exp2f(c0[2 * ((g) - 4)]); c0[2 * ((g) - 4) + 1] = __builtin_amdgcn_exp2f(c0[2 * ((g) - 4) + 1]); lsA += c0[2 * ((g) - 4)]; lsA += c0[2 * ((g) - 4) + 1]; \
            pc[((g) - 4) >> 2][((g) - 4) & 3] = pk2(c0[2 * ((g) - 4)], c0[2 * ((g) - 4) + 1]); } \
        else if ((g) >= 12) { c1[2 * ((g) - 12)] = __builtin_amdgcn_exp2f(c1[2 * ((g) - 12)]); c1[2 * ((g) - 12) + 1] = __builtin_amdgcn_exp2f(c1[2 * ((g) - 12) + 1]); lsA += c1[2 * ((g) - 12)]; lsA += c1[2 * ((g) - 12) + 1]; \
            pc[((g) - 4) >> 2][((g) - 4) & 3] = pk2(c1[2 * ((g) - 12)], c1[2 * ((g) - 12) + 1]); } \
        SBAR(); } while (0)
#define MLA_STEP(t_, c0, c1, n0, n1, pp, pc, BAR) do { \
        MLA_STK(((t_) + 3) & 3); MLA_STV(((t_) + 1) & 3); MLA_LDK((t_) + 4); MLA_LDV((t_) + 2); \
        const ldsp kbn = Kl + (((t_) + 1) & 3) * KBUF + q * KSTR + hi * 16; \
        const ldsp vbp = Vl + (((t_) + 3) & 3) * VBUF2 + vtb; \
        bf16x8 fr[3]; MLA_LOADF(0); MLA_LOADF(1); SBAR(); \
        MLA_GAP(0, c0, c1, n0, n1, pp, pc); MLA_GAP(1, c0, c1, n0, n1, pp, pc); MLA_GAP(2, c0, c1, n0, n1, pp, pc); MLA_GAP(3, c0, c1, n0, n1, pp, pc); \
        MLA_GAP(4, c0, c1, n0, n1, pp, pc); MLA_GAP(5, c0, c1, n0, n1, pp, pc); MLA_GAP(6, c0, c1, n0, n1, pp, pc); MLA_GAP(7, c0, c1, n0, n1, pp, pc); \
        MLA_GAP(8, c0, c1, n0, n1, pp, pc); MLA_GAP(9, c0, c1, n0, n1, pp, pc); MLA_GAP(10, c0, c1, n0, n1, pp, pc); MLA_GAP(11, c0, c1, n0, n1, pp, pc); \
        MLA_GAP(12, c0, c1, n0, n1, pp, pc); MLA_GAP(13, c0, c1, n0, n1, pp, pc); MLA_GAP(14, c0, c1, n0, n1, pp, pc); MLA_GAP(15, c0, c1, n0, n1, pp, pc); \
        MLA_GAP(16, c0, c1, n0, n1, pp, pc); MLA_GAP(17, c0, c1, n0, n1, pp, pc); MLA_GAP(18, c0, c1, n0, n1, pp, pc); MLA_GAP(19, c0, c1, n0, n1, pp, pc); \
        asm volatile("" : "+v"(n0), "+v"(n1), "+v"(o0), "+v"(o1));        \
        if (BAR) __syncthreads(); } while (0)
#pragma unroll 1
    for (int t = 0; t < NT; t += 2) {
        MLA_STEP(t, cA0, cA1, cB0, cB1, ppA, ppA, false);
        MLA_STEP(t + 1, cB0, cB1, cA0, cA1, ppA, ppA, true);
    }
    {
        const ldsp vb = Vl + ((NT - 1) & 3) * VBUF2 + vtb;
#pragma unroll
        for (int kk = 0; kk < 4; ++kk) { o0 = MFMA32(vfrag_tr(vb + kk * 16 * VR, 8 * VR), __builtin_bit_cast(bf16x8, ppA[kk]), o0); o1 = MFMA32(vfrag_tr(vb + 64 + kk * 16 * VR, 8 * VR), __builtin_bit_cast(bf16x8, ppA[kk]), o1); SBAR(); }
    }
    __syncthreads();
#undef MLA_LDK
#undef MLA_LDV
#undef MLA_STK
#undef MLA_STV
#undef MLA_LOADF
#undef MLA_GAP
#undef MLA_STEP
    float lsum = lsA + lsB;
    lsum = xor32_sum(lsum);
    const float il = 1.f / lsum;
    int lane2 = lane_id_v(); asm volatile("" : "+v"(lane2));
    const size_t tq2 = (size_t)b * SEQ + qb * 256 + wid * 32 + (lane2 & 31);
    bf16_t* dst = OC_ + tq2 * 1024 + 512 + h * 64 + 4 * (lane2 >> 5);
#pragma unroll
    for (int g = 0; g < 4; ++g) {
        *(u32x2*)(dst + 8 * g) = pack4((f32x4){o0[4 * g] * il, o0[4 * g + 1] * il, o0[4 * g + 2] * il, o0[4 * g + 3] * il});
        *(u32x2*)(dst + 32 + 8 * g) = pack4((f32x4){o1[4 * g] * il, o1[4 * g + 1] * il, o1[4 * g + 2] * il, o1[4 * g + 3] * il});
    }
}

DI void mla_unit_slow(ldsp lds, int b, int h, int qb, const bf16_t* Qm_, const bf16_t* Kn_, const bf16_t* Kr_, const bf16_t* Vm_, bf16_t* OC_, float ref, const int tid) {
    const int lane = tid & 63, wid = tid >> 6, q = lane & 31, hi = lane >> 5;
    const size_t tokb = (size_t)b * SEQ;
    const size_t tq = tokb + qb * 256 + wid * 32 + q;
    bf16x8 qf[6];
#pragma unroll
    for (int d0 = 0; d0 < 6; ++d0) qf[d0] = *(const bf16x8*)(Qm_ + tq * 768 + h * 96 + d0 * 16 + hi * 8);
    f32x16 o0, o1;
#pragma unroll
    for (int r = 0; r < 16; ++r) { o0[r] = 0.f; o1[r] = 0.f; }
    float lsum = 0.f;
    const int s_row = tid >> 3, s_part = tid & 7, r_row = (tid >> 2) & 63, r_part = tid & 3;
    const bf16_t* kn_src = Kn_ + (tokb + s_row) * 512 + h * 64 + s_part * 8;
    const bf16_t* v_src = Vm_ + (tokb + s_row) * 512 + h * 64 + s_part * 8;
    const bf16_t* kr_src = Kr_ + (tokb + r_row) * 32 + r_part * 8;
    const ldsp Kl = lds, Vl = lds + 2 * KBUF;
    u32x4 rk, rv, rr = (u32x4){0u, 0u, 0u, 0u};
    rk = *(const u32x4*)kn_src; rv = *(const u32x4*)v_src; if (tid < 256) rr = *(const u32x4*)kr_src;
#define MLA_STORE(buf) do { \
        *(LAS u32x4*)(Kl + (buf) * KBUF + s_row * KSTR + s_part * 16) = rk; \
        if (tid < 256) *(LAS u32x4*)(Kl + (buf) * KBUF + r_row * KSTR + 128 + r_part * 16) = rr; \
        LAS unsigned short* vt_ = (LAS unsigned short*)(Vl + (buf) * VBUF) + (s_part * 8) * (VSTR / 2) + s_row; \
        _Pragma("unroll") for (int j_ = 0; j_ < 8; ++j_) vt_[j_ * (VSTR / 2)] = (unsigned short)(rv[j_ >> 1] >> (16 * (j_ & 1))); } while (0)
    MLA_STORE(0);
    __syncthreads();
    for (int t = 0; t < SEQ / 64; ++t) {
        const int cur = t & 1;
        if (t + 1 < SEQ / 64) { const size_t off = (size_t)(t + 1) * 64;
            rk = *(const u32x4*)(kn_src + off * 512); rv = *(const u32x4*)(v_src + off * 512); if (tid < 256) rr = *(const u32x4*)(kr_src + off * 32); }
        f32x16 s0, s1;
#pragma unroll
        for (int r = 0; r < 16; ++r) { s0[r] = -ref; s1[r] = -ref; }
        const ldsp kb = Kl + cur * KBUF + q * KSTR + hi * 16;
#pragma unroll
        for (int d0 = 0; d0 < 6; ++d0) {
            const bf16x8 a0 = *(const LAS bf16x8*)(kb + d0 * 32);
            const bf16x8 a1 = *(const LAS bf16x8*)(kb + 32 * KSTR + d0 * 32);
            s0 = MFMA32(a0, qf[d0], s0); s1 = MFMA32(a1, qf[d0], s1);
        }
#pragma unroll
        for (int r = 0; r < 16; ++r) { s0[r] = __builtin_amdgcn_exp2f(s0[r]); s1[r] = __builtin_amdgcn_exp2f(s1[r]); }
        float ps = 0.f;
#pragma unroll
        for (int r = 0; r < 16; ++r) ps += s0[r] + s1[r];
        lsum += ps;
        bf16x8 pf[4]; pf[0] = pack8(s0, 0); pf[1] = pack8(s0, 1); pf[2] = pack8(s1, 0); pf[3] = pack8(s1, 1);
        const ldsp vb = Vl + cur * VBUF + q * VSTR + hi * 8;
#pragma unroll
        for (int kk = 0; kk < 4; ++kk) {
            o0 = MFMA32(vfrag(vb + kk * 32), pf[kk], o0);
            o1 = MFMA32(vfrag(vb + 32 * VSTR + kk * 32), pf[kk], o1);
        }
        if (t + 1 < SEQ / 64) MLA_STORE(cur ^ 1);
        __syncthreads();
    }
#undef MLA_STORE
    lsum = xor32_sum(lsum);
    const float il = 1.f / lsum;
    bf16_t* dst = OC_ + tq * 1024 + 512 + h * 64 + 4 * hi;
#pragma unroll
    for (int g = 0; g < 4; ++g) {
        *(u32x2*)(dst + 8 * g) = pack4((f32x4){o0[4 * g] * il, o0[4 * g + 1] * il, o0[4 * g + 2] * il, o0[4 * g + 3] * il});
        *(u32x2*)(dst + 32 + 8 * g) = pack4((f32x4){o1[4 * g] * il, o1[4 * g + 1] * il, o1[4 * g + 2] * il, o1[4 * g + 3] * il});
    }
}


constexpr int VS2 = 96;
typedef int i32x4 __attribute__((ext_vector_type(4)));
DI void dil_task(ldsp vscr, ldsp pscr, const int* pos, int cfg, int dil, int b, int h, int T0, int k, const bf16_t* Qd, const bf16_t* Kd, const bf16_t* Vd,
                 bf16_t* PART, float* LP, bf16_t* OC, float ref, float slope_l2, int lane) {
    const int tpr = 16 / dil, rs = k / tpr, sub = k % tpr, L = SEQ / dil, U0 = T0 / dil + 32 * sub;
    const int q = lane & 31, hi = lane >> 5;
    const size_t tokb = (size_t)b * SEQ;
    const size_t tq = tokb + rs + (size_t)dil * (U0 + q);
    const int lrow0 = lane >> 3, lch0 = lane & 7;
    const ldsp qscr = vscr + 32 * 192;
    {   u32x4 qc[4];
#pragma unroll
        for (int i = 0; i < 4; ++i) qc[i] = *(const u32x4*)(Qd + (tokb + rs + (size_t)dil * (U0 + 8 * i + lrow0)) * 512 + h * 64 + 8 * lch0);
#pragma unroll
        for (int i = 0; i < 4; ++i) *(LAS u32x4*)(qscr + (8 * i + lrow0) * 144 + lch0 * 16) = qc[i]; }
    bf16x8 qf[4];
#pragma unroll
    for (int d0 = 0; d0 < 4; ++d0) qf[d0] = *(const LAS bf16x8*)(qscr + q * 144 + d0 * 32 + hi * 16);
    f32x16 o0, o1;
#pragma unroll
    for (int r = 0; r < 16; ++r) { o0[r] = 0.f; o1[r] = 0.f; }
    float lsum = 0.f;
    const int posq = pos[tq];
    u32x4 kc[4], kn[4], vv[4], vvn[4]; int pk, pkn;
    const int lrow = lane >> 3, lch = lane & 7;
    const ldsp kscr = vscr + 32 * 192;
#define DIL_LOAD(KC, VV, PK, t_) do { const int Ut_ = U0 - 64 + 32 * (t_); \
        _Pragma("unroll") for (int i = 0; i < 4; ++i) { int uk_ = Ut_ + 8 * i + lrow; uk_ = uk_ < 0 ? 0 : (uk_ > L - 1 ? L - 1 : uk_); \
            const size_t tk_ = tokb + rs + (size_t)dil * uk_; \
            KC[i] = *(const u32x4*)(Kd + tk_ * 512 + h * 64 + 8 * lch); VV[i] = *(const u32x4*)(Vd + tk_ * 512 + h * 64 + 8 * lch); } \
        { int ukl_ = Ut_ + q; ukl_ = ukl_ < 0 ? 0 : (ukl_ > L - 1 ? L - 1 : ukl_); PK = pos[tokb + rs + (size_t)dil * ukl_]; } } while (0)
    DIL_LOAD(kc, vv, pk, 0);
#pragma unroll 1
    for (int t = 0; t < 5; ++t) {
        const int Ut = U0 - 64 + 32 * t;
        if (t < 4) DIL_LOAD(kn, vvn, pkn, t + 1);
        if (!(Ut + 31 < 0 || Ut >= L)) {
#pragma unroll
        for (int i = 0; i < 4; ++i) { *(LAS u32x4*)(vscr + (8 * i + lrow) * 192 + lch * 16) = vv[i]; *(LAS u32x4*)(kscr + (8 * i + lrow) * 144 + lch * 16) = kc[i]; }
        f32x16 s;
#pragma unroll
        for (int r = 0; r < 16; ++r) s[r] = -ref;
#pragma unroll
        for (int d0 = 0; d0 < 4; ++d0) s = MFMA32(*(const LAS bf16x8*)(kscr + q * 144 + d0 * 32 + hi * 16), qf[d0], s);
        float ps = 0.f;
        if (hi == 0) ((LAS int*)pscr)[q] = pk;
        i32x4 pk4[4];
#pragma unroll
        for (int g = 0; g < 4; ++g) pk4[g] = *(const LAS i32x4*)(pscr + (8 * g + 4 * hi) * 4);
        const float fbase = (float)(Ut - U0 - q + 4 * hi);
        if ((Ut >= 0) && (Ut + 31 < L)) {
#pragma unroll
            for (int r = 0; r < 16; ++r) {
                const float fd = fbase + (float)((r & 3) + 8 * (r >> 2));
                const float dist = (float)(pk4[r >> 2][r & 3] - posq);
                const float e = __builtin_amdgcn_exp2f(__builtin_fmaf(-slope_l2, __builtin_fabsf(dist), s[r]));
                const float p = (__builtin_fabsf(fd) <= 64.f) ? e : 0.f;
                s[r] = p; ps += p;
            }
        } else {
#pragma unroll
            for (int r = 0; r < 16; ++r) {
                const int uk = Ut + crow(r, hi);
                const float fd = fbase + (float)((r & 3) + 8 * (r >> 2));
                const float dist = (float)(pk4[r >> 2][r & 3] - posq);
                const float e = __builtin_amdgcn_exp2f(__builtin_fmaf(-slope_l2, __builtin_fabsf(dist), s[r]));
                const float p = ((__builtin_fabsf(fd) <= 64.f) && (uk >= 0) && (uk < L)) ? e : 0.f;
                s[r] = p; ps += p;
            }
        }
        lsum += ps;
        const bf16x8 pf0 = pack8(s, 0), pf1 = pack8(s, 1);
        const ldsp vb = vscr + (4 * hi + ((lane & 15) >> 2)) * 192 + (16 * ((lane >> 4) & 1) + 4 * (lane & 3)) * 2;
        o0 = MFMA32(vfrag_tr(vb, 8 * 192), pf0, o0);
        o0 = MFMA32(vfrag_tr(vb + 16 * 192, 8 * 192), pf1, o0);
        o1 = MFMA32(vfrag_tr(vb + 64, 8 * 192), pf0, o1);
        o1 = MFMA32(vfrag_tr(vb + 64 + 16 * 192, 8 * 192), pf1, o1);
        }
#pragma unroll
        for (int i = 0; i < 4; ++i) { kc[i] = kn[i]; vv[i] = vvn[i]; }
        pk = pkn;
    }
#undef DIL_LOAD
    lsum = xor32_sum(lsum);
    {
        const ldsp oscr = vscr;
#pragma unroll
        for (int g = 0; g < 4; ++g) {
            *(LAS f32x4*)(oscr + q * 272 + (8 * g + 4 * hi) * 4) = (f32x4){o0[4 * g], o0[4 * g + 1], o0[4 * g + 2], o0[4 * g + 3]};
            *(LAS f32x4*)(oscr + q * 272 + (32 + 8 * g + 4 * hi) * 4) = (f32x4){o1[4 * g], o1[4 * g + 1], o1[4 * g + 2], o1[4 * g + 3]};
        }
        if (hi == 0) ((LAS float*)(oscr + 8704))[q] = lsum;
#pragma unroll
        for (int i = 0; i < 4; ++i) {
            const int row = 8 * i + lrow0;
            const size_t tr = tokb + rs + (size_t)dil * (U0 + row);
            const f32x4 a0 = *(const LAS f32x4*)(oscr + row * 272 + lch0 * 32), a1 = *(const LAS f32x4*)(oscr + row * 272 + lch0 * 32 + 16);
            const float lrw = ((const LAS float*)(oscr + 8704))[row];
            if (cfg < 2) {
                u32x4 w; w.x = pk2(a0[0], a0[1]); w.y = pk2(a0[2], a0[3]); w.z = pk2(a1[0], a1[1]); w.w = pk2(a1[2], a1[3]);
                *(u32x4*)(PART + ((size_t)cfg * MTOK + tr) * 512 + h * 64 + 8 * lch0) = w;
                if (lch0 == 0) LP[((size_t)cfg * MTOK + tr) * 8 + h] = lrw;
            } else {
                const u32x4 p0 = *(const u32x4*)(PART + tr * 512 + h * 64 + 8 * lch0), p1 = *(const u32x4*)(PART + ((size_t)MTOK + tr) * 512 + h * 64 + 8 * lch0);
                const float il = 1.f / (lrw + LP[tr * 8 + h] + LP[((size_t)MTOK + tr) * 8 + h]);
                float v[8];
#pragma unroll
                for (int e = 0; e < 8; ++e) { const unsigned aw = p0[e >> 1], cw = p1[e >> 1];
                    const float av = __uint_as_float((e & 1) ? (aw & 0xffff0000u) : (aw << 16)), cv = __uint_as_float((e & 1) ? (cw & 0xffff0000u) : (cw << 16));
                    v[e] = ((e < 4 ? a0[e & 3] : a1[e & 3]) + av + cv) * il; }
                u32x4 w; w.x = pk2(v[0], v[1]); w.y = pk2(v[2], v[3]); w.z = pk2(v[4], v[5]); w.w = pk2(v[6], v[7]);
                *(u32x4*)(OC + tr * 1024 + h * 64 + 8 * lch0) = w;
            }
        }
    }
}

__global__ void __launch_bounds__(NTHREADS, 2) mega_fwd(Params P) {
    extern __shared__ __attribute__((aligned(16))) unsigned char lds_raw[];
    cg::grid_group grid = cg::this_grid();
    const ldsp lds = (ldsp)lds_raw;
    const int G0 = gridDim.x, blk0 = blockIdx.x;
    const int wid_s = __builtin_amdgcn_readfirstlane((int)threadIdx.x >> 6);
    { int lane0 = lane_id_v(); const int tid0 = wid_s * 64 + lane0;
      volatile LAS unsigned* st = (volatile LAS unsigned*)(lds + LDS_BYTES - 16);
      if (tid0 == 0) { st[0] = 0u; st[1] = 0u; }
      __syncthreads();
      (void)xcd_barrier_post((unsigned*)(PF(ws) + WS_BAR), st, tid0); }
#define GSYNC() do { int w_ = wid_s; asm volatile("" : "+s"(w_)); int l_ = lane_id_v(); asm volatile("" : "+v"(l_)); \
    XcdBarrier xb_; xb_.bar = (unsigned*)(PF(ws) + WS_BAR); xb_.x = xb_xcc_id(); xb_.st = (volatile LAS unsigned*)(lds + LDS_BYTES - 16); xcd_barrier(xb_, w_ * 64 + l_); } while (0)
#define PHASE_BEGIN() int blk = blk0, G = G0; asm volatile("" : "+s"(blk), "+s"(G)); int wid = wid_s; asm volatile("" : "+s"(wid)); int lane = lane_id_v(); asm volatile("" : "+v"(lane)); const int tid = wid * 64 + lane; \
    unsigned long long wsv_ = karg_u64((int)__builtin_offsetof(Params, ws)); asm volatile("" : "+s"(wsv_)); unsigned char* ws = gptr<unsigned char>(wsv_); const int gw = blk * 8 + wid, NGW = G * 8; (void)lane; (void)gw; (void)NGW
#define MOD ((float*)(ws + WS_MOD))
#define BIAS1 ((float*)(ws + WS_BIAS1))
#define BIAS2 ((float*)(ws + WS_BIAS2))
#define GS1 ((float*)(ws + WS_GS1))
#define GS2 ((float*)(ws + WS_GS2))
#define XA ((bf16_t*)(ws + WS_XA))
#define Qd ((bf16_t*)(ws + WS_QD))
#define Kd ((bf16_t*)(ws + WS_KD))
#define Vd ((bf16_t*)(ws + WS_VD))
#define Qm ((bf16_t*)(ws + WS_QM))
#define Kn ((bf16_t*)(ws + WS_KN))
#define Vm ((bf16_t*)(ws + WS_VM))
#define OC ((bf16_t*)(ws + WS_OC))
#define Kr ((bf16_t*)(ws + WS_KR))
#define CQ ((bf16_t*)(ws + WS_CQ))
#define CKV ((bf16_t*)(ws + WS_CKV))
#define PART ((bf16_t*)(ws + WS_PART))
#define LP ((float*)(ws + WS_LP))
#define SSQX ((float*)(ws + WS_SSQX))
#define SSQ2 ((float*)(ws + WS_SSQ2))
#define SSQCQ ((float*)(ws + WS_SSQCQ))
#define SSQCKV ((float*)(ws + WS_SSQCKV))
#define HB ((bf16_t*)(ws + WS_H))
#define RCOS ((float*)(ws + WS_RCOS))
#define RSIN ((float*)(ws + WS_RSIN))
#define WL(off) (ws + WS_W + (size_t)l * WS_WSTRIDE + (off))

    {
    PHASE_BEGIN();
    LAS float* vecs = (LAS float*)lds; LAS float* red = (LAS float*)(lds + 8192); LAS float* tscr = (LAS float*)(lds + 16384 + wid * 8704);
    if ((PH_MASK & 1) && (blk < 192 || G < 192)) {
        for (int i = tid; i < 2048; i += NTHREADS) { const float cv = PF(c)[i]; vecs[i] = cv / (1.f + __expf(-cv)); }
        __syncthreads();
        for (int u = blk; u < 192; u += G) { const int l = u / 96, nb = u % 96;
            gemv_unit(PF(w_mod) + (size_t)l * DM * 6144, 6144, 6144, nb, vecs, red, MOD + (l * 2 + 0) * 6144, MOD + (l * 2 + 1) * 6144, PF(b_mod) + l * 6144, tid); }
    }
    for (int i = blk * NTHREADS + tid; i < MTOK * 16; i += G * NTHREADS) {
        float sn, cs; sincos_rev((float)PF(pos)[i >> 4] * c_inv[i & 15], sn, cs); RCOS[i] = cs; RSIN[i] = sn; }
    if (PH_MASK & 2) {
        constexpr int I_IN = 16 * 64, I_QU = 4 * 24, I_KV = 2 * 32, I_OUT = 16 * 32, I_W1 = 16 * 128, I_W2 = 64 * 32, I_L = I_IN + I_QU + I_KV + I_OUT + I_W1 + I_W2;
        for (int it = gw; it < 2 * I_L; it += NGW) {
            const int l = it / I_L; int r = it % I_L;
            unsigned char* wl = ws + WS_W + (size_t)l * WS_WSTRIDE;
            if (r < I_IN) { transpose_item(PF(w_in) + (size_t)l * DM * WIN_COLS, DM, WIN_COLS, 64, (bf16_t*)(wl + WO_IN), nullptr, tscr, r, lane,
                    [](int Gp) { const int pn = Gp >> 3, bj = (Gp >> 2) & 1, wc = Gp & 3; const int lb = 256 * pn + 64 * wc + 32 * bj; return lb < WIN_COLS ? lb : -1; }); continue; }
            r -= I_IN;
            if (r < I_QU) { transpose_item(PF(w_q_up) + (size_t)l * 256 * 768, 256, 768, 24, (bf16_t*)(wl + WO_QU), PF(g_cq) + l * 256, tscr, r, lane,
                    [](int Gp) { const int pn = Gp >> 3, bj = (Gp >> 2) & 1, wc = Gp & 3; return pn < 2 ? (4 * pn + wc) * 96 + 32 * bj : (2 * wc + bj) * 96 + 64; }); continue; }
            r -= I_QU;
            if (r < I_KV) { transpose_item(PF(w_kv_up) + (size_t)l * 128 * 1024, 128, 1024, 32, (bf16_t*)(wl + WO_KV), PF(g_ckv) + l * 128, tscr, r, lane,
                    [](int Gp) { const int pn = Gp >> 3, bj = (Gp >> 2) & 1, wc = Gp & 3; return pn < 2 ? (4 * pn + wc) * 128 + 32 * bj : (4 * (pn - 2) + wc) * 128 + 64 + 32 * bj; }); continue; }
            r -= I_KV;
            if (r < I_OUT) { transpose_item(PF(w_out) + (size_t)l * DM * DM, DM, DM, 32, (bf16_t*)(wl + WO_OUT), nullptr, tscr, r, lane, [](int Gp) { return 32 * Gp; }); continue; }
            r -= I_OUT;
            if (r < I_W1) { transpose_item(PF(w_mlp_in) + (size_t)l * DM * FF, DM, FF, 128, (bf16_t*)(wl + WO_W1), nullptr, tscr, r, lane, [](int Gp) { return 32 * Gp; }); continue; }
            r -= I_W1;
            transpose_item(PF(w_mlp_out) + (size_t)l * FF * DM, FF, DM, 32, (bf16_t*)(wl + WO_W2), nullptr, tscr, r, lane, [](int Gp) { return 32 * Gp; });
        }
    }
    }
    GSYNC();
    if (G0 > (1 << 24)) grid.sync();

    {
    PHASE_BEGIN();
    LAS float* vecs = (LAS float*)lds; LAS float* red = (LAS float*)(lds + 8192);
    if (PH_MASK & 4) for (int u = blk; u < 192; u += G) {
        const int l = u / 96, rem = u % 96; const bool first = rem < 32;
        const int sh_off = first ? 0 : 3072;
        __syncthreads();
        for (int i = tid; i < 2048; i += NTHREADS) vecs[i] = MOD[(l * 2 + (i >> 10)) * 6144 + sh_off + (i & 1023)];
        __syncthreads();
        if (first) gemv_unit(PF(w_in) + (size_t)l * DM * WIN_COLS, WIN_COLS, WIN_PAD, rem, vecs, red, BIAS1 + (l * 2 + 0) * WIN_PAD, BIAS1 + (l * 2 + 1) * WIN_PAD, nullptr, tid);
        else gemv_unit(PF(w_mlp_in) + (size_t)l * DM * FF, FF, FF, rem - 32, vecs, red, BIAS2 + (l * 2 + 0) * FF, BIAS2 + (l * 2 + 1) * FF, nullptr, tid);
    }
    if (blk == G - 1 && tid < 2) {
        const int l = tid;
        float Gq = 0.f, Gk = 0.f, Gqn = 0.f, Gkn = 0.f, Gqr = 0.f, Gkr = 0.f;
#pragma unroll 1
        for (int i = 0; i < 64; ++i) { Gq = fmaxf(Gq, fabsf(PF(g_q_dil)[l * 64 + i])); Gk = fmaxf(Gk, fabsf(PF(g_k_dil)[l * 64 + i]));
            Gqn = fmaxf(Gqn, fabsf(PF(g_q_nope)[l * 64 + i])); Gkn = fmaxf(Gkn, fabsf(PF(g_k_nope)[l * 64 + i])); }
#pragma unroll 1
        for (int i = 0; i < 32; ++i) { Gqr = fmaxf(Gqr, fabsf(PF(g_q_rope)[l * 32 + i])); Gkr = fmaxf(Gkr, fabsf(PF(g_k_rope)[l * 32 + i])); }
        ((float*)(ws + WS_REFS))[l * 2 + 0] = 64.f * Gq * Gk * QS_D;
        ((float*)(ws + WS_REFS))[l * 2 + 1] = (64.f * Gqn * Gkn + 32.f * Gqr * Gkr) * QS_M;
    }
    for (int i = blk * NTHREADS + tid; i < 4096; i += G * NTHREADS) {
        const int lb = i >> 10, c = i & 1023, l = lb >> 1;
        GS1[i] = PF(g_norm_mix)[l * DM + c] * (1.f + MOD[lb * 6144 + 1024 + c]);
        GS2[i] = PF(g_norm_mlp)[l * DM + c] * (1.f + MOD[lb * 6144 + 4096 + c]);
    }
    for (int m0 = 4 * gw; m0 < MTOK; m0 += 4 * NGW) {
        f32x4 xv[4][4];
#pragma unroll
        for (int r = 0; r < 4; ++r)
#pragma unroll
            for (int j = 0; j < 4; ++j) xv[r][j] = *(const f32x4*)(PF(x) + (size_t)(m0 + r) * DM + 4 * lane + 256 * j);
        const int b = m0 >> 13;
#pragma unroll
        for (int r = 0; r < 4; ++r) { const int m = m0 + r; float s = 0.f;
#pragma unroll
            for (int j = 0; j < 4; ++j) { const int c = 4 * lane + 256 * j;
                const f32x4 v = xv[r][j], gg = *(const f32x4*)(PF(g_norm_mix) + c), sc = *(const f32x4*)(MOD + b * 6144 + 1024 + c);
                s += sq4(v); *(u32x2*)(XA + (size_t)m * DM + c) = pack4(v * gg * (sc + 1.f)); }
            s = wave_sum(s);
            if (lane < 16) SSQX[(size_t)m * 16 + lane] = lane == 0 ? s : 0.f; }
    }
    }
    GSYNC();

#pragma unroll 1
    for (int l = 0; l < 2; ++l) {
        if (PH_MASK & 8) {
            PHASE_BEGIN();
            pg8::Gemm g{XA, (const bf16_t*)WL(WO_IN), MTOK, WIN_PAD, DM}; pg8::StaticOrder S; S.init(MTOK, WIN_PAD, G, blk);
            EpiIn E{ws, BIAS1 + (size_t)l * 2 * WIN_PAD, PF(g_q_dil) + l * 64, PF(g_k_dil) + l * 64, PF(g_k_rope) + l * 32};
            pg8::gemm_phase<EpiIn, pg8::StaticOrder, true, true>(lds, g, S, E, tid);
        }
        GSYNC();
        if (PH_MASK & 16) {
            PHASE_BEGIN();
            int Kq = 256; asm volatile("" : "+s"(Kq));
            pg8::Gemm g{CQ, (const bf16_t*)WL(WO_QU), MTOK, 768, Kq}; pg8::StaticOrder S; S.init(MTOK, 768, G, blk);
            EpiQup E{SSQCQ, PF(g_q_nope) + l * 64, PF(g_q_rope) + l * 32, RCOS, RSIN, Qm};
            pg8::gemm_phase<EpiQup, pg8::StaticOrder, true, true>(lds, g, S, E, tid);
        }
        __syncthreads();
        if (PH_MASK & 32) {
            PHASE_BEGIN();
            int Kk = 128; asm volatile("" : "+s"(Kk));
            pg8::Gemm g{CKV, (const bf16_t*)WL(WO_KV), MTOK, 1024, Kk}; pg8::StaticOrder S; S.init(MTOK, 1024, G, blk);
            EpiKvup E{SSQCKV, PF(g_k_nope) + l * 64, Kn, Vm};
            pg8::gemm_phase<EpiKvup, pg8::StaticOrder, true, true>(lds, g, S, E, tid);
        }
        GSYNC();
        {
            PHASE_BEGIN();
            const float ref_d = ((const float*)(ws + WS_REFS))[l * 2 + 0], ref_m = ((const float*)(ws + WS_REFS))[l * 2 + 1];
            if (PH_MASK & 64) for (int u = blk; u < 256; u += G) {
                const int h = u & 7, tb = (u >> 3) & 15, b = u >> 7;
                const float slope_l2 = LOG2E / (float)(1 << (h + 1));
                const ldsp vscr = lds + wid * 10752;
#pragma unroll 1
                for (int cfg = 0; cfg < 3; ++cfg) {
                    if (cfg == 2) __syncthreads();
                    const int dil = cfg == 0 ? 1 : (cfg == 1 ? 4 : 16);
#pragma unroll 1
                    for (int k = wid; k < 16; k += 8) dil_task(vscr, lds + 8 * 10752 + wid * 128, PF(pos), cfg, dil, b, h, tb * 512, k, Qd, Kd, Vd, PART, LP, OC, ref_d, slope_l2, lane);
                }
                __syncthreads();
            }
            if (ref_m < 100.f) {
                for (int u = blk; u < 512; u += G) { const int x = u & 7, j = (u >> 3) & 31, i = u >> 8, bh = 2 * x + i;
                    mla_unit(lds, bh >> 3, bh & 7, j, Qm, Kn, Kr, Vm, OC, 0.f, wid); }
            } else {
                for (int u = blk; u < 512; u += G) { const int x = u & 7, j = (u >> 3) & 31, i = u >> 8, bh = 2 * x + i;
                    mla_unit_slow(lds, bh >> 3, bh & 7, j, Qm, Kn, Kr, Vm, OC, ref_m, tid); }
            }
        }
        GSYNC();
        if (PH_MASK & 256) {
            PHASE_BEGIN();
            pg8::Gemm g{OC, (const bf16_t*)WL(WO_OUT), MTOK, DM, DM}; pg8::StaticOrder S; S.init(MTOK, DM, G, blk);
            EpiRes E{l == 0 ? PF(x) : (const float*)PF(out), PF(out), MOD + (size_t)l * 2 * 6144 + 2048, GS2 + (size_t)l * 2 * DM, XA, SSQ2};
            pg8::gemm_phase<EpiRes, pg8::StaticOrder, true, true>(lds, g, S, E, tid);
        }
        GSYNC();
        if (PH_MASK & 512) {
            PHASE_BEGIN();
            pg8::Gemm g{XA, (const bf16_t*)WL(WO_W1), MTOK, FF, DM}; pg8::StaticOrder S; S.init(MTOK, FF, G, blk);
            EpiUp E{SSQ2, BIAS2 + (size_t)l * 2 * FF, HB};
            pg8::gemm_phase<EpiUp, pg8::StaticOrder, true, true>(lds, g, S, E, tid);
        }
        GSYNC();
        if (PH_MASK & 1024) {
            PHASE_BEGIN();
            pg8::Gemm g{HB, (const bf16_t*)WL(WO_W2), MTOK, DM, FF}; pg8::StaticOrder S; S.init(MTOK, DM, G, blk);
            EpiRes E{(const float*)PF(out), PF(out), MOD + (size_t)l * 2 * 6144 + 5120, l == 0 ? GS1 + 2 * DM : nullptr, XA, SSQX};
            pg8::gemm_phase<EpiRes, pg8::StaticOrder, true, true>(lds, g, S, E, tid);
        }
        if (l == 0) GSYNC();
    }
}

extern "C" void kernel_launch(void* const* d_in, const int* in_sizes, int n_in, void* d_out, int out_size, void* d_ws, size_t ws_size, hipStream_t stream) {
    static int grid = 0;
    if (grid == 0) {
        if (n_in != 21 || ws_size < WS_END) { fprintf(stderr, "kernel_launch: unexpected n_in %d / ws_size %zu\n", n_in, ws_size); grid = -1; return; }
        int dev = 0, cus = 0, per_cu = 0;
        hipGetDevice(&dev);
        hipDeviceGetAttribute(&cus, hipDeviceAttributeMultiprocessorCount, dev);
        if (hipFuncSetAttribute((const void*)mega_fwd, hipFuncAttributeMaxDynamicSharedMemorySize, LDS_BYTES) != hipSuccess) { fprintf(stderr, "kernel_launch: hipFuncSetAttribute failed\n"); }
        if (hipOccupancyMaxActiveBlocksPerMultiprocessor(&per_cu, (const void*)mega_fwd, NTHREADS, LDS_BYTES) != hipSuccess || per_cu < 1) { fprintf(stderr, "kernel_launch: occupancy query says %d\n", per_cu); per_cu = 1; }
        (void)hipGetLastError();
        grid = cus;
        if (grid > 256) grid = 256;
    }
    if (grid < 0) return;
    Params p{};
    p.x = (const float*)d_in[0]; p.c = (const float*)d_in[1]; p.pos = (const int*)d_in[2]; p.w_mod = (const float*)d_in[3]; p.b_mod = (const float*)d_in[4];
    p.g_norm_mix = (const float*)d_in[5]; p.w_in = (const float*)d_in[6]; p.g_q_dil = (const float*)d_in[7]; p.g_k_dil = (const float*)d_in[8]; p.g_cq = (const float*)d_in[9];
    p.w_q_up = (const float*)d_in[10]; p.g_ckv = (const float*)d_in[11]; p.w_kv_up = (const float*)d_in[12]; p.g_q_nope = (const float*)d_in[13]; p.g_q_rope = (const float*)d_in[14];
    p.g_k_nope = (const float*)d_in[15]; p.g_k_rope = (const float*)d_in[16]; p.w_out = (const float*)d_in[17]; p.g_norm_mlp = (const float*)d_in[18];
    p.w_mlp_in = (const float*)d_in[19]; p.w_mlp_out = (const float*)d_in[20]; p.out = (float*)d_out; p.ws = (unsigned char*)d_ws;
    if (hipMemsetAsync((char*)d_ws + WS_BAR, 0, WS_BAR_BYTES, stream) != hipSuccess) { fprintf(stderr, "kernel_launch: memset failed\n"); return; }
    void* args[] = {&p};
    hipError_t e = hipLaunchCooperativeKernel((const void*)mega_fwd, dim3(grid), dim3(NTHREADS), args, LDS_BYTES, stream);
    if (e != hipSuccess) fprintf(stderr, "kernel_launch: cooperative launch failed: %s (grid %d)\n", hipGetErrorString(e), grid);
}
```

```cpp
#include <hip/hip_runtime.h>
#include <hip/hip_cooperative_groups.h>
#include <cstdio>
#include <cstdint>
namespace cg = cooperative_groups;
namespace pg8 {
#define PG8_LAS __attribute__((address_space(3)))
typedef unsigned short bf16_t;
typedef short bf16x8 __attribute__((ext_vector_type(8)));
typedef float f32x4 __attribute__((ext_vector_type(4)));
typedef unsigned u32x4 __attribute__((ext_vector_type(4)));
constexpr int BM = 256, BK = 64, HALF = 128, HTB = HALF * BK * 2  , STAGE_BYTES = 8 * HTB, NXCD = 8, WGM = 8;

__host__ __device__ __forceinline__ int lds_byte(int r, int c) { const int st = (r >> 4) * 2 + (c >> 5), rr = r & 15, cc = c & 31, ob = rr * 64 + cc * 2; return st * 1024 + (ob ^ (((ob >> 9) & 1) << 5)); }
__host__ __device__ __forceinline__ void stage_rc(int b, int& R, int& C) { const int st = b / 1024, sb = b % 1024, swz = sb ^ (((sb >> 9) & 1) << 5); R = (st >> 1) * 16 + swz / 64; C = (st & 1) * 32 + (swz % 64) / 2; }
__host__ __device__ __forceinline__ int perm32(int rho) { const int n = rho >> 4, i = rho & 15; return 8 * (i >> 2) + 4 * n + (i & 3); }

struct Unit { int pm, pn; };
struct Gemm { const bf16_t* A; const bf16_t* Bt; int M, N, K; };

struct StaticOrder {
    int nM, nN, nwg, G, c;
    __host__ __device__ void init(int M, int N, int G_, int c_) { nM = M / BM; nN = N / BM; nwg = nM * nN; G = G_; c = c_; }
    __host__ __device__ bool next(int i, Unit& u) const {
        const long L = (long)i * G + c; if (L >= nwg) return false;
        int wgid = (int)L; { const int q = nwg / NXCD, r = nwg % NXCD, xcd = wgid % NXCD, off = wgid / NXCD; wgid = (xcd < r ? xcd * (q + 1) : r * (q + 1) + (xcd - r) * q) + off; }
        const int nig = WGM * nN, gid = wgid / nig, fm = gid * WGM, gsz = (nM - fm) < WGM ? (nM - fm) : WGM;
        u.pm = fm + ((wgid % nig) % gsz); u.pn = (wgid % nig) / gsz; return true;
    }
    __device__ __forceinline__ void a_ready(const Unit&) const {}
    __device__ __forceinline__ void done(const Unit&) const {}
};

__device__ __forceinline__ unsigned cvt_pk_bf16(float lo, float hi) { unsigned r; asm volatile("v_cvt_pk_bf16_f32 %0, %1, %2" : "=v"(r) : "v"(lo), "v"(hi)); return r; }
template <class Epi, class Sched, bool ALIGN_EPI = false, bool SP2 = false>
__device__ __forceinline__ void gemm_phase(PG8_LAS unsigned char* lds, const Gemm g, const Sched& S, const Epi& E, const int tid_in) {
    int tid_ = tid_in; asm volatile("" : "+v"(tid_));
    const int tid = tid_, wid = __builtin_amdgcn_readfirstlane(tid >> 6), lane = tid & 63, wr = wid >> 2, wc = wid & 3, fr = lane & 15, fq = lane >> 4;
    const int K = g.K, nt = K / BK;
    unsigned voffA[2], voffB[2];
#pragma unroll
    for (int i = 0; i < 2; ++i) { int R, C; stage_rc(tid * 16 + i * 8192, R, C); const int Rb = Epi::PERM ? ((R & ~31) + perm32(R & 31)) : R;
        voffA[i] = (unsigned)(R * K + C) * 2u; voffB[i] = (unsigned)(Rb * K + C) * 2u; }
    const size_t kstep = (size_t)(BK * 2);
    const size_t hstep = (size_t)HALF * K * 2;
    const size_t tstep = 2 * hstep;
    const unsigned ldsw = (unsigned)wid * 1024u;
    const int aoff = lds_byte(wr * 64 + fr, fq * 8), boff = lds_byte(wc * 32 + fr, fq * 8);
#define PG8_SA(b, h) (((b) * 2 + (h)) * HTB)
#define PG8_SB(b, h) ((4 + (b) * 2 + (h)) * HTB)
#define PG8_STAGE(bufoff, gbase, voff) do { _Pragma("unroll") for (int _i = 0; _i < 2; ++_i) \
        __builtin_amdgcn_global_load_lds((const unsigned*)((const char*)(gbase) + (voff)[_i]), (PG8_LAS unsigned*)(lds + (bufoff) + ldsw + _i * 8192), 16, 0, 0); } while (0)
#define PG8_LDA(dst, b, h) do { _Pragma("unroll") for (int m = 0; m < 4; ++m) _Pragma("unroll") for (int k = 0; k < 2; ++k) dst[m][k] = *(const PG8_LAS bf16x8*)(lds + PG8_SA(b, h) + aoff + m * 2048 + k * 1024); } while (0)
#define PG8_LDB(dst, b, h) do { _Pragma("unroll") for (int n = 0; n < 2; ++n) _Pragma("unroll") for (int k = 0; k < 2; ++k) dst[n][k] = *(const PG8_LAS bf16x8*)(lds + PG8_SB(b, h) + boff + n * 2048 + k * 1024); } while (0)
#define PG8_MMA(ai, bj, At, Bt) do { __builtin_amdgcn_s_setprio(1); _Pragma("unroll") for (int m = 0; m < 4; ++m) _Pragma("unroll") for (int n = 0; n < 2; ++n) _Pragma("unroll") for (int k = 0; k < 2; ++k) \
        acc[ai][bj][m][n] = __builtin_amdgcn_mfma_f32_16x16x32_bf16(Bt[n][k], At[m][k], acc[ai][bj][m][n], 0, 0, 0); __builtin_amdgcn_s_setprio(0); } while (0)
#define PG8_WAIT_V(n) asm volatile("s_waitcnt vmcnt(" #n ")" ::: "memory")
#define PG8_WAIT_L(n) asm volatile("s_waitcnt lgkmcnt(" #n ")" ::: "memory")
#define PG8_BAR __builtin_amdgcn_s_barrier()
#define PG8_SCHED __builtin_amdgcn_sched_barrier(0)
    Unit cur, nxt; int ui = 0;
    if (!S.next(0, cur)) return;
    f32x4 acc[2][2][4][2];
#pragma unroll
    for (int a = 0; a < 2; ++a)
#pragma unroll
        for (int b = 0; b < 2; ++b)
#pragma unroll
            for (int m = 0; m < 4; ++m)
#pragma unroll
                for (int n = 0; n < 2; ++n) acc[a][b][m][n] = (f32x4){0.f, 0.f, 0.f, 0.f};
    bf16x8 At[4][2], B0[2][2], B1[2][2];
    const char* cA = (const char*)g.A + (size_t)cur.pm * tstep; const char* cB = (const char*)g.Bt + (size_t)cur.pn * tstep;
    S.a_ready(cur);
    if constexpr (SP2) {
        PG8_STAGE(PG8_SB(0, 0), cB, voffB); PG8_STAGE(PG8_SB(0, 1), cB + hstep, voffB); PG8_STAGE(PG8_SA(0, 0), cA, voffA); PG8_STAGE(PG8_SA(0, 1), cA + hstep, voffA);
        if (wr == 1) PG8_BAR;
        PG8_WAIT_V(2); PG8_BAR;
        PG8_STAGE(PG8_SB(1, 0), cB + kstep, voffB); PG8_STAGE(PG8_SA(1, 0), cA + kstep, voffA); PG8_STAGE(PG8_SB(1, 1), cB + hstep + kstep, voffB);
        PG8_WAIT_V(6); PG8_BAR;
    } else {
        PG8_STAGE(PG8_SB(0, 0), cB, voffB); PG8_STAGE(PG8_SA(0, 0), cA, voffA); PG8_STAGE(PG8_SB(0, 1), cB + hstep, voffB); PG8_STAGE(PG8_SA(0, 1), cA + hstep, voffA);
        if (wr == 1) PG8_BAR;
        PG8_WAIT_V(4); PG8_BAR;
        PG8_STAGE(PG8_SB(1, 0), cB + kstep, voffB); PG8_STAGE(PG8_SA(1, 0), cA + kstep, voffA); PG8_STAGE(PG8_SB(1, 1), cB + hstep + kstep, voffB);
        PG8_WAIT_V(6); PG8_BAR;
    }
    for (;;) {
        const bool has_next = S.next(ui + 1, nxt);
        const char* nA = has_next ? (const char*)g.A + (size_t)nxt.pm * tstep : cA; const char* nB = has_next ? (const char*)g.Bt + (size_t)nxt.pn * tstep : cB;
        for (int t = 0; t < nt; t += 2) {
            const bool last = (t == nt - 2);
            const char* a1 = cA + (size_t)(t + 1) * kstep;
            const char* a2 = last ? nA : cA + (size_t)(t + 2) * kstep; const char* b2 = last ? nB : cB + (size_t)(t + 2) * kstep;
            const char* a3 = a2 + kstep; const char* b3 = b2 + kstep;
            if (last && has_next) S.a_ready(nxt);
            if constexpr (SP2) {
            PG8_LDB(B0, 0, 0); PG8_LDB(B1, 0, 1); PG8_SCHED; PG8_LDA(At, 0, 0); PG8_STAGE(PG8_SA(1, 1), a1 + hstep, voffA);
            PG8_WAIT_V(8); PG8_WAIT_L(0); PG8_BAR; PG8_MMA(0, 0, At, B0); PG8_MMA(0, 1, At, B1); PG8_BAR; PG8_SCHED;
            PG8_LDA(At, 0, 1); PG8_STAGE(PG8_SB(0, 0), b2, voffB); PG8_STAGE(PG8_SB(0, 1), b2 + hstep, voffB); PG8_STAGE(PG8_SA(0, 0), a2, voffA);
            PG8_WAIT_V(8); PG8_WAIT_L(0); PG8_BAR; PG8_MMA(1, 0, At, B0); PG8_MMA(1, 1, At, B1); PG8_BAR; PG8_SCHED;
            PG8_LDB(B0, 1, 0); PG8_LDB(B1, 1, 1); PG8_SCHED; PG8_LDA(At, 1, 0); PG8_STAGE(PG8_SA(0, 1), a2 + hstep, voffA);
            PG8_WAIT_V(8); PG8_WAIT_L(0); PG8_BAR; PG8_MMA(0, 0, At, B0); PG8_MMA(0, 1, At, B1); PG8_BAR; PG8_SCHED;
            PG8_LDA(At, 1, 1); PG8_STAGE(PG8_SB(1, 0), b3, voffB); PG8_STAGE(PG8_SB(1, 1), b3 + hstep, voffB); PG8_STAGE(PG8_SA(1, 0), a3, voffA);
            PG8_WAIT_V(8); PG8_WAIT_L(0); PG8_BAR; PG8_MMA(1, 0, At, B0); PG8_MMA(1, 1, At, B1); PG8_BAR; PG8_SCHED;
            } else {
            PG8_LDB(B0, 0, 0); PG8_SCHED; PG8_LDA(At, 0, 0); PG8_STAGE(PG8_SA(1, 1), a1 + hstep, voffA);
            PG8_WAIT_L(8); PG8_BAR; PG8_WAIT_L(0); PG8_MMA(0, 0, At, B0); PG8_BAR; PG8_SCHED;
            PG8_LDB(B1, 0, 1); PG8_STAGE(PG8_SB(0, 0), b2, voffB);
            PG8_BAR; PG8_WAIT_L(0); PG8_MMA(0, 1, At, B1); PG8_BAR;
            PG8_LDA(At, 0, 1); PG8_STAGE(PG8_SA(0, 0), a2, voffA);
            PG8_BAR; PG8_WAIT_L(0); PG8_MMA(1, 0, At, B0); PG8_BAR; PG8_SCHED;
            PG8_STAGE(PG8_SB(0, 1), b2 + hstep, voffB);
            PG8_WAIT_V(6); PG8_BAR; PG8_MMA(1, 1, At, B1); PG8_BAR;
            PG8_LDB(B0, 1, 0); PG8_SCHED; PG8_LDA(At, 1, 0); PG8_STAGE(PG8_SA(0, 1), a2 + hstep, voffA);
            PG8_WAIT_L(8); PG8_BAR; PG8_WAIT_L(0); PG8_MMA(0, 0, At, B0); PG8_BAR; PG8_SCHED;
            PG8_LDB(B1, 1, 1); PG8_STAGE(PG8_SB(1, 0), b3, voffB);
            PG8_BAR; PG8_WAIT_L(0); PG8_MMA(0, 1, At, B1); PG8_BAR;
            PG8_LDA(At, 1, 1); PG8_STAGE(PG8_SA(1, 0), a3, voffA);
            PG8_BAR; PG8_WAIT_L(0); PG8_MMA(1, 0, At, B0); PG8_BAR; PG8_SCHED;
            PG8_STAGE(PG8_SB(1, 1), b3 + hstep, voffB);
            PG8_WAIT_V(6); PG8_BAR; PG8_MMA(1, 1, At, B1); PG8_BAR;
            }
        }
        if constexpr (ALIGN_EPI) { if (wr == 0) PG8_BAR; }
        if constexpr (!Epi::AFTER_DRAIN) { E(acc, cur, wr, wc, fr, fq); S.done(cur); }
        if (!has_next) break;
#pragma unroll
        for (int a = 0; a < 2; ++a)
#pragma unroll
            for (int b = 0; b < 2; ++b)
#pragma unroll
                for (int m = 0; m < 4; ++m)
#pragma unroll
                    for (int n = 0; n < 2; ++n) acc[a][b][m][n] = (f32x4){0.f, 0.f, 0.f, 0.f};
        cur = nxt; cA = nA; cB = nB; ++ui;
        if constexpr (ALIGN_EPI) { if (wr == 1) PG8_BAR; }
    }
    PG8_WAIT_V(0);
    if constexpr (!ALIGN_EPI) { if (wr == 0) PG8_BAR; }
    PG8_BAR;
    if constexpr (Epi::AFTER_DRAIN) { E.fused(acc, cur, wr, wc, fr, fq, lds, wid, lane); S.done(cur); }
#undef PG8_SA
#undef PG8_SB
#undef PG8_STAGE
#undef PG8_LDA
#undef PG8_LDB
#undef PG8_MMA
#undef PG8_WAIT_V
#undef PG8_WAIT_L
#undef PG8_BAR
#undef PG8_SCHED
}
}

#define DI __device__ __forceinline__
#define LAS __attribute__((address_space(3)))
using pg8::f32x4; using pg8::bf16_t; using pg8::bf16x8; using pg8::Unit;
typedef unsigned u32x2 __attribute__((ext_vector_type(2)));
typedef unsigned u32x4 __attribute__((ext_vector_type(4)));
typedef short s16x4 __attribute__((ext_vector_type(4)));
typedef float f32x16 __attribute__((ext_vector_type(16)));
typedef float f32x2_t __attribute__((ext_vector_type(2)));
typedef __bf16 bf16x2_t __attribute__((ext_vector_type(2)));
typedef LAS unsigned char* ldsp;

constexpr int MTOK = 16384, DM = 1024, SEQ = 8192, FF = 4096;
constexpr int WIN_COLS = 1952, WIN_PAD = 2048;
constexpr float EPS = 1e-6f;
constexpr float LOG2E = 1.4426950408889634f;
constexpr float QS_D = 0.125f * LOG2E;
constexpr float QS_M = 0.10206207261596575f * LOG2E;
#ifndef PH_MASK
#define PH_MASK 0xFFFF
#endif
constexpr int NTHREADS = 512;
constexpr int LDS_BYTES = 131072 + 2048;

constexpr size_t MiB = 1u << 20;
constexpr size_t WS_BAR = 1u << 20, WS_BAR_BYTES = 16384;
constexpr size_t WS_REFS = 240 * 1024;
constexpr size_t WS_MOD = 0, WS_BIAS1 = 98304, WS_BIAS2 = 131072, WS_GS1 = 196608, WS_GS2 = 212992;
constexpr size_t WS_W = 2 * MiB, WS_WSTRIDE = 23 * MiB;
constexpr size_t WO_IN = 0, WO_QU = 4 * MiB, WO_KV = 4 * MiB + 512 * 1024, WO_OUT = 5 * MiB, WO_W1 = 7 * MiB, WO_W2 = 15 * MiB;
constexpr size_t WS_XA = 48 * MiB;
constexpr size_t WS_QD = 80 * MiB, WS_KD = 96 * MiB, WS_VD = 112 * MiB, WS_QM = 128 * MiB, WS_KN = 152 * MiB, WS_VM = 168 * MiB, WS_OC = 184 * MiB;
constexpr size_t WS_KR = 216 * MiB, WS_CQ = 217 * MiB, WS_CKV = 225 * MiB, WS_PART = 217 * MiB, WS_LP = 249 * MiB;
constexpr size_t WS_SSQX = 250 * MiB, WS_SSQ2 = 251 * MiB, WS_SSQCQ = 252 * MiB, WS_SSQCKV = 252 * MiB + 256 * 1024;
constexpr size_t WS_H = 80 * MiB;
constexpr size_t WS_RCOS = 253 * MiB, WS_RSIN = 254 * MiB;
constexpr size_t WS_END = 255 * MiB;

__constant__ float c_inv[16] = {1.000000000e+00f, 5.623413324e-01f, 3.162277639e-01f, 1.778279394e-01f, 1.000000015e-01f, 5.623413250e-02f, 3.162277490e-02f, 1.778279431e-02f,
                                9.999999776e-03f, 5.623413250e-03f, 3.162277630e-03f, 1.778279431e-03f, 1.000000047e-03f, 5.623413017e-04f, 3.162277571e-04f, 1.778279402e-04f};

struct Params {
    const float* x; const float* c; const int* pos; const float* w_mod; const float* b_mod; const float* g_norm_mix; const float* w_in;
    const float* g_q_dil; const float* g_k_dil; const float* g_cq; const float* w_q_up; const float* g_ckv; const float* w_kv_up;
    const float* g_q_nope; const float* g_q_rope; const float* g_k_nope; const float* g_k_rope; const float* w_out; const float* g_norm_mlp;
    const float* w_mlp_in; const float* w_mlp_out; float* out; unsigned char* ws;
};

typedef __attribute__((address_space(4))) const char* c4ptr_t; typedef __attribute__((address_space(4))) const unsigned long long* c4u64_t;
#define GASP __attribute__((address_space(1)))
DI unsigned long long karg_u64(int off) { c4ptr_t kp = (c4ptr_t)__builtin_amdgcn_kernarg_segment_ptr(); asm volatile("" : "+s"(kp)); return *(c4u64_t)(kp + off); }
template <class T> DI T* gptr(unsigned long long v) { return (T*)(GASP T*)v; }
template <class P> struct pointee_of; template <class T> struct pointee_of<T*> { typedef T type; };
#define PF(name) (gptr<pointee_of<decltype(Params::name)>::type>(karg_u64((int)__builtin_offsetof(Params, name))))
DI int lane_id_v() { int l; asm volatile("v_mbcnt_lo_u32_b32 %0, -1, 0\n\tv_mbcnt_hi_u32_b32 %0, -1, %0" : "=v"(l)); return l; }
DI unsigned pk2(float lo, float hi) { f32x2_t v = {lo, hi}; bf16x2_t b = __builtin_convertvector(v, bf16x2_t); return __builtin_bit_cast(unsigned, b); }
DI u32x2 pack4(f32x4 v) { u32x2 w; w.x = pk2(v[0], v[1]); w.y = pk2(v[2], v[3]); return w; }
DI float sum4(f32x4 v) { return (v[0] + v[1]) + (v[2] + v[3]); }
DI float sq4(f32x4 v) { return (v[0] * v[0] + v[1] * v[1]) + (v[2] * v[2] + v[3] * v[3]); }
DI float xor16_sum(float v) { auto r = __builtin_amdgcn_permlane16_swap(__float_as_uint(v), __float_as_uint(v), false, false); return __uint_as_float(r[0]) + __uint_as_float(r[1]); }
DI float xor32_sum(float v) { auto r = __builtin_amdgcn_permlane32_swap(__float_as_uint(v), __float_as_uint(v), false, false); return __uint_as_float(r[0]) + __uint_as_float(r[1]); }
template <int K> DI float swz_xor(float v) { return __uint_as_float((unsigned)__builtin_amdgcn_ds_swizzle((int)__float_as_uint(v), (K << 10) | 0x1f)); }
DI float red_fq(float s) { return xor32_sum(xor16_sum(s)); }
DI float wave_sum(float v) { v += swz_xor<1>(v); v += swz_xor<2>(v); v += swz_xor<4>(v); v += swz_xor<8>(v); return xor32_sum(xor16_sum(v)); }
DI float umax_abs(const float* g, int n) { float r = 0.f; for (int i = 0; i < n; ++i) r = fmaxf(r, fabsf(g[i])); return r; }
DI float fadd_s(float a, float b) { float r; asm("v_add_f32_e32 %0, %1, %2" : "=v"(r) : "v"(a), "v"(b)); return r; }
DI float rsq(float v) { return __builtin_amdgcn_rsqf(v); }
DI float bf2f(unsigned short u) { return __uint_as_float(((unsigned)u) << 16); }
DI void sincos_rev(float ang, float& s, float& c) {
    const double rev = (double)ang * 0.15915494309189535;
    const float f = (float)(rev - __builtin_rint(rev));
    s = __builtin_amdgcn_sinf(f); c = __builtin_amdgcn_cosf(f);
}

#define GAS __attribute__((address_space(1)))
#define XB_TMO      128
#define XB_XCNT(j)  (256  + 64 * (j))
#define XB_XSUB(j)  (1280 + 64 * (j))
#define XB_XGEN(j)  (2304 + 64 * (j))
#define XB_TOP      3328
#define XB_TOPGEN   3392
#define XCD_BAR_WORDS 3456
#define XB_SPIN_CAP (1u << 18)

__device__ __forceinline__ unsigned xb_ld(unsigned* p)              { return __hip_atomic_load(p, __ATOMIC_RELAXED, __HIP_MEMORY_SCOPE_AGENT); }
__device__ __forceinline__ unsigned xb_add(unsigned* p, unsigned v) { return __hip_atomic_fetch_add(p, v, __ATOMIC_RELAXED, __HIP_MEMORY_SCOPE_AGENT); }
__device__ __forceinline__ unsigned xb_xcc_id() { return (unsigned)__builtin_amdgcn_s_getreg((3 << 11) | 20) & 0xFu; }
#define XB_SPIN(cond, bar) do { unsigned _sp = 0; while (cond) { __builtin_amdgcn_s_sleep(1); \
    if ((++_sp & 255u) == 0u) { if (xb_ld(&(bar)[XB_TMO])) break; if (_sp > XB_SPIN_CAP) { atomicAdd(&(bar)[XB_TMO], 1u); break; } } } } while (0)

struct XcdBarrier {
    unsigned* bar; unsigned x;
    volatile LAS unsigned* st;
};

__device__ __forceinline__ XcdBarrier xcd_barrier_post(unsigned* bar, volatile LAS unsigned* st, const int tid) {
    XcdBarrier b; b.bar = bar; b.x = xb_xcc_id(); b.st = st;
    if (tid == 0) (void)xb_add(&bar[XB_XCNT(b.x)], 1u);
    return b;
}
__device__ __forceinline__ void xcd_barrier_complete(unsigned* bar, unsigned x, unsigned& nloc, unsigned& nx) {
    const unsigned G = gridDim.x * gridDim.y * gridDim.z;
    unsigned sum, cnt, mine, sp = 0u;
    for (;;) {
        sum = 0u; cnt = 0u; mine = 0u;
#pragma unroll
        for (unsigned j = 0; j < 16; ++j) { const unsigned c = xb_ld(&bar[XB_XCNT(j)]); sum += c; cnt += (c > 0u) ? 1u : 0u; mine = (j == x) ? c : mine; }
        if (sum == G) break;
        __builtin_amdgcn_s_sleep(1);
        if ((++sp & 255u) == 0u) { if (xb_ld(&bar[XB_TMO])) break; if (sp > XB_SPIN_CAP) { atomicAdd(&bar[XB_TMO], 1u); break; } }
    }
    nloc = mine > 0u ? mine : 1u; nx = cnt > 0u ? cnt : 1u;
}

__device__ __forceinline__ void xcd_barrier(const XcdBarrier& b, const int tid) {
    asm volatile("s_waitcnt vmcnt(0)" ::: "memory");
    __syncthreads();
    if (tid == 0) {
        unsigned* bar = b.bar;
        __builtin_amdgcn_s_waitcnt(0);
        unsigned nloc = b.st[0], nx = b.st[1];
        if (nloc == 0u) { xcd_barrier_complete(bar, b.x, nloc, nx); b.st[0] = nloc; b.st[1] = nx; }
        const unsigned old = xb_add(&bar[XB_XSUB(b.x)], 1u);
        const unsigned gen = old / nloc;
        if (old + 1u == (gen + 1u) * nloc) {
            __builtin_amdgcn_fence(__ATOMIC_RELEASE, "agent");
            asm volatile("s_waitcnt vmcnt(0)" ::: "memory");
            const unsigned og = xb_add(&bar[XB_TOP], 1u);
            const unsigned tg = og / nx;
            if (og + 1u == (tg + 1u) * nx) xb_add(&bar[XB_TOPGEN], 1u);
            else XB_SPIN(xb_ld(&bar[XB_TOPGEN]) == tg, bar);
            __builtin_amdgcn_fence(__ATOMIC_ACQUIRE, "agent");
            xb_add(&bar[XB_XGEN(b.x)], 1u);
            asm volatile("s_waitcnt vmcnt(0)" ::: "memory");
        } else {
            XB_SPIN(xb_ld(&bar[XB_XGEN(b.x)]) == gen, bar);
            __builtin_amdgcn_fence(__ATOMIC_ACQUIRE, "agent");
            asm volatile("s_waitcnt vmcnt(0)" ::: "memory");
        }
    }
    __syncthreads();
}


#define EPI_FENCE() asm volatile("" ::: "memory")
struct EpiIn {
    static constexpr bool PERM = true, AFTER_DRAIN = false;
    unsigned char* wsb; const float* bias; const float* gq; const float* gk; const float* gkr;
    DI void operator()(const f32x4 (&acc)[2][2][4][2], const Unit& u, int wr, int wc, int fr, int fq) const {
        const float* ssq = (const float*)(wsb + WS_SSQX); const float* rcos = (const float*)(wsb + WS_RCOS); const float* rsin = (const float*)(wsb + WS_RSIN);
        bf16_t* Qd = (bf16_t*)(wsb + WS_QD); bf16_t* Kd = (bf16_t*)(wsb + WS_KD); bf16_t* Vd = (bf16_t*)(wsb + WS_VD);
        bf16_t* CQ = (bf16_t*)(wsb + WS_CQ); bf16_t* CKV = (bf16_t*)(wsb + WS_CKV); bf16_t* Kr = (bf16_t*)(wsb + WS_KR);
        float* ssq_cq = (float*)(wsb + WS_SSQCQ); float* ssq_ckv = (float*)(wsb + WS_SSQCKV);
        const int b = u.pm >> 5, pn = u.pn, lc0 = 64 * wc + 8 * fq;
        const float* bp = bias + b * WIN_PAD + 256 * pn + lc0;
        f32x4 bv[2][2], gv[2][2];
#pragma unroll
        for (int bj = 0; bj < 2; ++bj)
#pragma unroll
            for (int n = 0; n < 2; ++n) { bv[bj][n] = *(const f32x4*)(bp + 32 * bj + 4 * n); gv[bj][n] = (f32x4){1.f, 1.f, 1.f, 1.f}; }
        if (pn < 4) { const float* g = (pn < 2 ? gq : gk) + 8 * fq;
#pragma unroll
            for (int bj = 0; bj < 2; ++bj)
#pragma unroll
                for (int n = 0; n < 2; ++n) gv[bj][n] = *(const f32x4*)(g + 32 * bj + 4 * n);
        } else if (pn == 7) { gv[0][0] = *(const f32x4*)(gkr + 8 * fq); gv[0][1] = *(const f32x4*)(gkr + 8 * fq + 4); }
        float rstdv[2][4];
#pragma unroll
        for (int ai = 0; ai < 2; ++ai)
#pragma unroll
            for (int m = 0; m < 4; ++m) { const int row = u.pm * 256 + ai * 128 + wr * 64 + m * 16 + fr;
                rstdv[ai][m] = rsq(red_fq(sum4(*(const f32x4*)(ssq + (size_t)row * 16 + 4 * fq))) * (1.f / 1024.f) + EPS); }
#define EPI_ST16(dst_, v0_, v1_) do { u32x4 w_; w_.x = pk2((v0_)[0], (v0_)[1]); w_.y = pk2((v0_)[2], (v0_)[3]); w_.z = pk2((v1_)[0], (v1_)[1]); w_.w = pk2((v1_)[2], (v1_)[3]); *(u32x4*)(dst_) = w_; } while (0)
#pragma unroll
        for (int ai = 0; ai < 2; ++ai)
#pragma unroll
            for (int m = 0; m < 4; ++m) {
                const int row = u.pm * 256 + ai * 128 + wr * 64 + m * 16 + fr;
                const float rstd = rstdv[ai][m];
                f32x4 z[2][2]; float ss = 0.f;
#pragma unroll
                for (int bj = 0; bj < 2; ++bj)
#pragma unroll
                    for (int n = 0; n < 2; ++n) { z[bj][n] = acc[ai][bj][m][n] * rstd + bv[bj][n]; ss += sq4(z[bj][n]); }
                if (pn < 4) {
                    ss = red_fq(ss);
                    const float r = rsq(ss * (1.f / 64.f) + EPS) * (pn < 2 ? QS_D : 1.f);
                    bf16_t* dst = (pn < 2 ? Qd : Kd) + (size_t)row * 512 + (pn & 1) * 256 + lc0;
#pragma unroll
                    for (int bj = 0; bj < 2; ++bj) EPI_ST16(dst + 32 * bj, z[bj][0] * r * gv[bj][0], z[bj][1] * r * gv[bj][1]);
                } else if (pn < 6) {
                    bf16_t* dst = Vd + (size_t)row * 512 + (pn - 4) * 256 + lc0;
#pragma unroll
                    for (int bj = 0; bj < 2; ++bj) EPI_ST16(dst + 32 * bj, z[bj][0], z[bj][1]);
                } else if (pn == 6) {
                    ss = red_fq(ss);
                    bf16_t* dst = CQ + (size_t)row * 256 + lc0;
#pragma unroll
                    for (int bj = 0; bj < 2; ++bj) EPI_ST16(dst + 32 * bj, z[bj][0], z[bj][1]);
                    if (fq == 0) ssq_cq[(size_t)row * 4 + wc] = ss;
                } else {
                    if (wc < 2) {
                        ss = red_fq(ss);
                        bf16_t* dst = CKV + (size_t)row * 128 + lc0;
#pragma unroll
                        for (int bj = 0; bj < 2; ++bj) EPI_ST16(dst + 32 * bj, z[bj][0], z[bj][1]);
                        if (fq == 0) ssq_ckv[(size_t)row * 2 + wc] = ss;
                    } else if (wc == 2) {
                        const float s8 = red_fq(sq4(z[0][0]) + sq4(z[0][1]));
                        const float r = rsq(s8 * (1.f / 32.f) + EPS);
                        const float sg = fq < 2 ? -1.f : 1.f;
                        f32x4 o0, o1;
#pragma unroll
                        for (int n = 0; n < 2; ++n) {
                            const f32x4 y = z[0][n] * r * gv[0][n];
                            const f32x4 cv = *(const f32x4*)(rcos + (size_t)row * 16 + 8 * (fq & 1) + 4 * n), sv = *(const f32x4*)(rsin + (size_t)row * 16 + 8 * (fq & 1) + 4 * n);
                            f32x4 o;
#pragma unroll
                            for (int e = 0; e < 4; ++e) {
                                auto sw = __builtin_amdgcn_permlane32_swap(__float_as_uint(y[e]), __float_as_uint(y[e]), false, false);
                                const float p = __uint_as_float(fq < 2 ? sw[1] : sw[0]);
                                o[e] = y[e] * cv[e] + p * sv[e] * sg; }
                            if (n == 0) o0 = o; else o1 = o;
                        }
                        EPI_ST16(Kr + (size_t)row * 32 + 8 * fq, o0, o1);
                    }
                }
                EPI_FENCE();
            }
#undef EPI_ST16
    }
};

struct EpiQup {
    static constexpr bool PERM = true, AFTER_DRAIN = false;
    const float* ssq_cq; const float* gqn; const float* gqr; const float* rcos; const float* rsin; bf16_t* Qm;
    DI void operator()(const f32x4 (&acc)[2][2][4][2], const Unit& u, int wr, int wc, int fr, int fq) const {
        const int pn = u.pn;
        float rstdv[2][4];
#pragma unroll
        for (int ai = 0; ai < 2; ++ai)
#pragma unroll
            for (int m = 0; m < 4; ++m) { const int row = u.pm * 256 + ai * 128 + wr * 64 + m * 16 + fr;
                rstdv[ai][m] = rsq(sum4(*(const f32x4*)(ssq_cq + (size_t)row * 4)) * (1.f / 256.f) + EPS); }
#pragma unroll
        for (int ai = 0; ai < 2; ++ai)
#pragma unroll
            for (int m = 0; m < 4; ++m) {
                const int row = u.pm * 256 + ai * 128 + wr * 64 + m * 16 + fr;
                const float rstd = rstdv[ai][m];
                f32x4 z[2][2];
#pragma unroll
                for (int bj = 0; bj < 2; ++bj)
#pragma unroll
                    for (int n = 0; n < 2; ++n) z[bj][n] = acc[ai][bj][m][n] * rstd;
                if (pn < 2) {
                    float ss = (sq4(z[0][0]) + sq4(z[0][1])) + (sq4(z[1][0]) + sq4(z[1][1]));
                    ss = red_fq(ss);
                    const float r = rsq(ss * (1.f / 64.f) + EPS) * QS_M;
                    bf16_t* dst = Qm + (size_t)row * 768 + (4 * pn + wc) * 96 + 8 * fq;
#pragma unroll
                    for (int bj = 0; bj < 2; ++bj) { const f32x4 y0 = z[bj][0] * r * *(const f32x4*)(gqn + 8 * fq + 32 * bj), y1 = z[bj][1] * r * *(const f32x4*)(gqn + 8 * fq + 32 * bj + 4);
                        u32x4 w; w.x = pk2(y0[0], y0[1]); w.y = pk2(y0[2], y0[3]); w.z = pk2(y1[0], y1[1]); w.w = pk2(y1[2], y1[3]); *(u32x4*)(dst + 32 * bj) = w; }
                } else {
                    const float sg = fq < 2 ? -1.f : 1.f;
#pragma unroll
                    for (int bj = 0; bj < 2; ++bj) {
                        const float s8 = red_fq(sq4(z[bj][0]) + sq4(z[bj][1]));
                        const float r = rsq(s8 * (1.f / 32.f) + EPS) * QS_M;
                        f32x4 o0, o1;
#pragma unroll
                        for (int n = 0; n < 2; ++n) {
                            const f32x4 y = z[bj][n] * r * *(const f32x4*)(gqr + 8 * fq + 4 * n);
                            const f32x4 cv = *(const f32x4*)(rcos + (size_t)row * 16 + 8 * (fq & 1) + 4 * n), sv = *(const f32x4*)(rsin + (size_t)row * 16 + 8 * (fq & 1) + 4 * n);
                            f32x4 o;
#pragma unroll
                            for (int e = 0; e < 4; ++e) {
                                auto sw = __builtin_amdgcn_permlane32_swap(__float_as_uint(y[e]), __float_as_uint(y[e]), false, false);
                                const float p = __uint_as_float(fq < 2 ? sw[1] : sw[0]);
                                o[e] = y[e] * cv[e] + p * sv[e] * sg; }
                            if (n == 0) o0 = o; else o1 = o;
                        }
                        bf16_t* dst = Qm + (size_t)row * 768 + (2 * wc + bj) * 96 + 64 + 8 * fq;
                        u32x4 w; w.x = pk2(o0[0], o0[1]); w.y = pk2(o0[2], o0[3]); w.z = pk2(o1[0], o1[1]); w.w = pk2(o1[2], o1[3]); *(u32x4*)dst = w;
                    }
                }
            }
    }
};

struct EpiKvup {
    static constexpr bool PERM = true, AFTER_DRAIN = false;
    const float* ssq_ckv; const float* gkn; bf16_t* Kn; bf16_t* Vm;
    DI void operator()(const f32x4 (&acc)[2][2][4][2], const Unit& u, int wr, int wc, int fr, int fq) const {
        const int pn = u.pn;
        float rstdv[2][4];
#pragma unroll
        for (int ai = 0; ai < 2; ++ai)
#pragma unroll
            for (int m = 0; m < 4; ++m) { const int row = u.pm * 256 + ai * 128 + wr * 64 + m * 16 + fr;
                const f32x2_t sp = *(const f32x2_t*)(ssq_ckv + (size_t)row * 2); rstdv[ai][m] = rsq((sp[0] + sp[1]) * (1.f / 128.f) + EPS); }
#pragma unroll
        for (int ai = 0; ai < 2; ++ai)
#pragma unroll
            for (int m = 0; m < 4; ++m) {
                const int row = u.pm * 256 + ai * 128 + wr * 64 + m * 16 + fr;
                const float rstd = rstdv[ai][m];
                f32x4 z[2][2];
#pragma unroll
                for (int bj = 0; bj < 2; ++bj)
#pragma unroll
                    for (int n = 0; n < 2; ++n) z[bj][n] = acc[ai][bj][m][n] * rstd;
                if (pn < 2) {
                    float ss = (sq4(z[0][0]) + sq4(z[0][1])) + (sq4(z[1][0]) + sq4(z[1][1]));
                    ss = red_fq(ss);
                    const float r = rsq(ss * (1.f / 64.f) + EPS);
                    bf16_t* dst = Kn + (size_t)row * 512 + (4 * pn + wc) * 64 + 8 * fq;
#pragma unroll
                    for (int bj = 0; bj < 2; ++bj) { const f32x4 y0 = z[bj][0] * r * *(const f32x4*)(gkn + 8 * fq + 32 * bj), y1 = z[bj][1] * r * *(const f32x4*)(gkn + 8 * fq + 32 * bj + 4);
                        u32x4 w; w.x = pk2(y0[0], y0[1]); w.y = pk2(y0[2], y0[3]); w.z = pk2(y1[0], y1[1]); w.w = pk2(y1[2], y1[3]); *(u32x4*)(dst + 32 * bj) = w; }
                } else {
                    bf16_t* dst = Vm + (size_t)row * 512 + (4 * (pn - 2) + wc) * 64 + 8 * fq;
#pragma unroll
                    for (int bj = 0; bj < 2; ++bj) { u32x4 w; w.x = pk2(z[bj][0][0], z[bj][0][1]); w.y = pk2(z[bj][0][2], z[bj][0][3]); w.z = pk2(z[bj][1][0], z[bj][1][1]); w.w = pk2(z[bj][1][2], z[bj][1][3]);
                        *(u32x4*)(dst + 32 * bj) = w; }
                }
            }
    }
};

struct EpiRes {
    static constexpr bool PERM = true, AFTER_DRAIN = false;
    const float* xin; float* out; const float* gate; const float* gs; bf16_t* XA; float* ssq;
    DI void operator()(const f32x4 (&acc)[2][2][4][2], const Unit& u, int wr, int wc, int fr, int fq) const {
        const int b = u.pm >> 5, c0 = u.pn * 256 + wc * 32 + 8 * fq;
        f32x4 gt[2][2], gsv[2][2];
#pragma unroll
        for (int bj = 0; bj < 2; ++bj)
#pragma unroll
            for (int n = 0; n < 2; ++n) { gt[bj][n] = *(const f32x4*)(gate + b * 6144 + c0 + 128 * bj + 4 * n);
                gsv[bj][n] = gs ? *(const f32x4*)(gs + b * DM + c0 + 128 * bj + 4 * n) : (f32x4){0.f, 0.f, 0.f, 0.f}; }
        f32x4 xc[2][2], xn[2][2];
#pragma unroll
        for (int bj = 0; bj < 2; ++bj)
#pragma unroll
            for (int n = 0; n < 2; ++n) xc[bj][n] = *(const f32x4*)(xin + (size_t)(u.pm * 256 + wr * 64 + fr) * DM + c0 + 128 * bj + 4 * n);
#pragma unroll
        for (int rg = 0; rg < 8; ++rg) {
            const int ai = rg >> 2, m = rg & 3;
            const int row = u.pm * 256 + ai * 128 + wr * 64 + m * 16 + fr;
            const size_t off = (size_t)row * DM + c0;
            if (rg < 7) { const int ai2 = (rg + 1) >> 2, m2 = (rg + 1) & 3; const size_t off2 = (size_t)(u.pm * 256 + ai2 * 128 + wr * 64 + m2 * 16 + fr) * DM + c0;
#pragma unroll
                for (int bj = 0; bj < 2; ++bj)
#pragma unroll
                    for (int n = 0; n < 2; ++n) xn[bj][n] = *(const f32x4*)(xin + off2 + 128 * bj + 4 * n); }
            float ss = 0.f;
#pragma unroll
            for (int bj = 0; bj < 2; ++bj) {
                const f32x4 xo0 = xc[bj][0] + gt[bj][0] * acc[ai][bj][m][0], xo1 = xc[bj][1] + gt[bj][1] * acc[ai][bj][m][1];
                *(f32x4*)(out + off + 128 * bj) = xo0; *(f32x4*)(out + off + 128 * bj + 4) = xo1;
                if (gs) { ss += sq4(xo0) + sq4(xo1); const f32x4 y0 = xo0 * gsv[bj][0], y1 = xo1 * gsv[bj][1];
                    u32x4 w; w.x = pk2(y0[0], y0[1]); w.y = pk2(y0[2], y0[3]); w.z = pk2(y1[0], y1[1]); w.w = pk2(y1[2], y1[3]);
                    *(u32x4*)(XA + off + 128 * bj) = w; }
            }
            if (gs) { ss = red_fq(ss); if (fq == 0) ssq[(size_t)row * 16 + 4 * u.pn + wc] = ss; }
#pragma unroll
            for (int bj = 0; bj < 2; ++bj)
#pragma unroll
                for (int n = 0; n < 2; ++n) xc[bj][n] = xn[bj][n];
        }
    }
};

struct EpiUp {
    static constexpr bool PERM = true, AFTER_DRAIN = false;
    const float* ssq; const float* bias; bf16_t* H;
    DI void operator()(const f32x4 (&acc)[2][2][4][2], const Unit& u, int wr, int wc, int fr, int fq) const {
        const int b = u.pm >> 5, c0 = u.pn * 256 + wc * 32 + 8 * fq;
        f32x4 bv[2][2];
#pragma unroll
        for (int bj = 0; bj < 2; ++bj)
#pragma unroll
            for (int n = 0; n < 2; ++n) bv[bj][n] = *(const f32x4*)(bias + b * FF + c0 + 128 * bj + 4 * n);
        float rstdv[2][4];
#pragma unroll
        for (int ai = 0; ai < 2; ++ai)
#pragma unroll
            for (int m = 0; m < 4; ++m) { const int row = u.pm * 256 + ai * 128 + wr * 64 + m * 16 + fr;
                rstdv[ai][m] = rsq(red_fq(sum4(*(const f32x4*)(ssq + (size_t)row * 16 + 4 * fq))) * (1.f / 1024.f) + EPS); }
#pragma unroll
        for (int ai = 0; ai < 2; ++ai)
#pragma unroll
            for (int m = 0; m < 4; ++m) {
                const int row = u.pm * 256 + ai * 128 + wr * 64 + m * 16 + fr;
                const float rstd = rstdv[ai][m];
                bf16_t* dst = H + (size_t)row * FF + c0;
#pragma unroll
                for (int bj = 0; bj < 2; ++bj) {
                    f32x4 z0 = acc[ai][bj][m][0] * rstd + bv[bj][0], z1 = acc[ai][bj][m][1] * rstd + bv[bj][1];
#pragma unroll
                    for (int e = 0; e < 4; ++e) { const float t0 = fmaxf(z0[e], 0.f), t1 = fmaxf(z1[e], 0.f); z0[e] = t0 * t0; z1[e] = t1 * t1; }
                    u32x4 w; w.x = pk2(z0[0], z0[1]); w.y = pk2(z0[2], z0[3]); w.z = pk2(z1[0], z1[1]); w.w = pk2(z1[2], z1[3]);
                    *(u32x4*)(dst + 128 * bj) = w;
                }
            }
    }
};

template <class LB>
DI void transpose_item(const float* W, int K, int N, int NpG  , bf16_t* WT, const float* gk, LAS float* scr, int item, int lane, LB lbase) {
    const int kb = item / NpG, G = item % NpG, k0 = 64 * kb;
    const int lb = lbase(G);
#pragma unroll
    for (int i = 0; i < 8; ++i) { const int kk = 8 * i + (lane >> 3), c4 = lane & 7;
        f32x4 v = (f32x4){0.f, 0.f, 0.f, 0.f};
        if (lb >= 0) { v = *(const f32x4*)(W + (size_t)(k0 + kk) * N + lb + 4 * c4); if (gk) v = v * gk[k0 + kk]; }
        LAS float* d = scr + kk * 33 + 4 * c4; d[0] = v[0]; d[1] = v[1]; d[2] = v[2]; d[3] = v[3]; }
    asm volatile("s_waitcnt lgkmcnt(0)" ::: "memory");
    const int c = lane & 7;
#pragma unroll
    for (int j = 0; j < 4; ++j) { const int n = (lane >> 3) + 8 * j; const LAS float* s = scr + (8 * c) * 33 + n;
        u32x4 o; o.x = pk2(s[0 * 33], s[1 * 33]); o.y = pk2(s[2 * 33], s[3 * 33]); o.z = pk2(s[4 * 33], s[5 * 33]); o.w = pk2(s[6 * 33], s[7 * 33]);
        *(u32x4*)(WT + (size_t)(32 * G + n) * K + k0 + 8 * c) = o; }
    asm volatile("s_waitcnt lgkmcnt(0)" ::: "memory");
}

DI void gemv_unit(const float* W, int N, int Nout, int nb, const LAS float* vecs, LAS float* red, float* out0, float* out1, const float* addend, int tid) {
    const int wid = tid >> 6, lane = tid & 63, n = nb * 64 + lane; const bool ok = n < N;
    float a0 = 0.f, a1 = 0.f;
    const float* wp = W + (size_t)(wid * 128) * N + (ok ? n : 0);
#pragma unroll 32
    for (int k = 0; k < 128; ++k) { const float w = ok ? wp[(size_t)k * N] : 0.f; a0 += vecs[wid * 128 + k] * w; a1 += vecs[1024 + wid * 128 + k] * w; }
    red[(wid * 2 + 0) * 64 + lane] = a0; red[(wid * 2 + 1) * 64 + lane] = a1;
    __syncthreads();
    if (tid < 128) { const int bb = tid >> 6, ln = tid & 63; float s = 0.f;
#pragma unroll
        for (int w = 0; w < 8; ++w) s += red[(w * 2 + bb) * 64 + ln];
        const int nn = nb * 64 + ln; if (nn < Nout) (bb ? out1 : out0)[nn] = s + ((addend && nn < N) ? addend[nn] : 0.f); }
    __syncthreads();
}

#define MFMA32(a, b, c) __builtin_amdgcn_mfma_f32_32x32x16_bf16((a), (b), (c), 0, 0, 0)
DI int crow(int r, int hi) { return (r & 3) + 8 * (r >> 2) + 4 * hi; }
DI bf16x8 pack8(const f32x16& p, int s) { u32x4 w; w.x = pk2(p[8 * s + 0], p[8 * s + 1]); w.y = pk2(p[8 * s + 2], p[8 * s + 3]); w.z = pk2(p[8 * s + 4], p[8 * s + 5]); w.w = pk2(p[8 * s + 6], p[8 * s + 7]); return __builtin_bit_cast(bf16x8, w); }
typedef short v4i16_t __attribute__((ext_vector_type(4)));
DI bf16x8 vfrag_tr(const LAS unsigned char* p, int second) { const s16x4 lo = __builtin_bit_cast(s16x4, __builtin_amdgcn_ds_read_tr16_b64_v4i16((LAS v4i16_t*)p)), hi = __builtin_bit_cast(s16x4, __builtin_amdgcn_ds_read_tr16_b64_v4i16((LAS v4i16_t*)(p + second))); return (bf16x8){lo[0], lo[1], lo[2], lo[3], hi[0], hi[1], hi[2], hi[3]}; }
DI bf16x8 vfrag(const LAS unsigned char* p) { const s16x4 lo = *(const LAS s16x4*)p, hi = *(const LAS s16x4*)(p + 16); return (bf16x8){lo[0], lo[1], lo[2], lo[3], hi[0], hi[1], hi[2], hi[3]}; }

constexpr int KSTR = 208, VSTR = 136, KBUF = 64 * KSTR, VBUF = 64 * VSTR;
#define SBAR() __builtin_amdgcn_sched_barrier(0)
DI void mla_unit(ldsp lds, int b, int h, int qb, const bf16_t* Qm_, const bf16_t* Kn_, const bf16_t* Kr_, const bf16_t* Vm_, bf16_t* OC_, float ref, const int wid) {
    int lane = lane_id_v(); asm volatile("" : "+v"(lane));
    const int tid = wid * 64 + lane, q = lane & 31, hi = lane >> 5;
    constexpr int NT = SEQ / 64;
    constexpr int VR = 192, VBUF2 = 64 * VR;
    const int rot = (qb * 4) & (NT - 1);
    const size_t tokb = (size_t)b * SEQ;
    bf16x8 qf[6];
    { const size_t tq = tokb + qb * 256 + wid * 32 + q;
#pragma unroll
    for (int d0 = 0; d0 < 6; ++d0) qf[d0] = *(const bf16x8*)(Qm_ + tq * 768 + h * 96 + d0 * 16 + hi * 8); }
    f32x16 o0, o1, negref;
#pragma unroll
    for (int r = 0; r < 16; ++r) { o0[r] = 0.f; o1[r] = 0.f; negref[r] = 0.f; }
    float lsA = 0.f, lsB = 0.f;
    const int s_row = tid >> 3, s_part = tid & 7, r_row = (tid >> 2) & 63, r_part = tid & 3;
    const char* kn_base = (const char*)(Kn_ + tokb * 512 + h * 64);
    const char* kr_base = (const char*)(Kr_ + tokb * 32);
    const char* v_base = (const char*)(Vm_ + tokb * 512 + h * 64);
    const unsigned kn_vo = (unsigned)(s_row * 512 + s_part * 8) * 2u, kr_vo = (unsigned)(r_row * 32 + r_part * 8) * 2u, v_vo = kn_vo;
    const ldsp Kl = lds, Vl = lds + 4 * KBUF;
    const int vtb = (4 * hi + ((lane & 15) >> 2)) * VR + (16 * ((lane >> 4) & 1) + 4 * (lane & 3)) * 2;
    u32x4 rk, rv, rr = (u32x4){0u, 0u, 0u, 0u};
#define MLA_LDK(t_) do { const unsigned tt_ = (unsigned)((t_) + rot) & (NT - 1); unsigned long long pk_ = (unsigned long long)(kn_base + (size_t)tt_ * (64 * 512 * 2)), pr_ = (unsigned long long)(kr_base + (size_t)tt_ * (64 * 32 * 2)); \
        asm volatile("" : "+s"(pk_), "+s"(pr_)); rk = *(const u32x4*)(gptr<const char>(pk_) + kn_vo); rr = *(const u32x4*)(gptr<const char>(pr_) + kr_vo); } while (0)
#define MLA_LDV(t_) do { const unsigned tt_ = (unsigned)((t_) + rot) & (NT - 1); unsigned long long pv_ = (unsigned long long)(v_base + (size_t)tt_ * (64 * 512 * 2)); asm volatile("" : "+s"(pv_)); rv = *(const u32x4*)(gptr<const char>(pv_) + v_vo); } while (0)
#define MLA_STK(buf) do { *(LAS u32x4*)(Kl + (buf) * KBUF + s_row * KSTR + s_part * 16) = rk; \
        *(LAS u32x4*)(Kl + (buf) * KBUF + r_row * KSTR + 128 + r_part * 16) = rr; } while (0)
#define MLA_STV(buf) do { *(LAS u32x4*)(Vl + (buf) * VBUF2 + s_row * VR + s_part * 16) = rv; } while (0)
    {
        u32x4 k0_, r0_, k1_, r1_, k2_, r2_, v0_;
        MLA_LDK(0); k0_ = rk; r0_ = rr; MLA_LDK(1); k1_ = rk; r1_ = rr; MLA_LDK(2); k2_ = rk; r2_ = rr; MLA_LDV(0); v0_ = rv;
        rk = k0_; rr = r0_; MLA_STK(0); rk = k1_; rr = r1_; MLA_STK(1); rk = k2_; rr = r2_; MLA_STK(2); rv = v0_; MLA_STV(0);
    }
    for (int i = tid; i < VBUF2 / 4; i += NTHREADS) ((LAS unsigned*)(Vl + 3 * VBUF2))[i] = 0u;
    MLA_LDK(3); MLA_LDV(1);
    __syncthreads();
    f32x16 cA0 = negref, cA1 = negref, cB0, cB1;
    {
        const ldsp kb = Kl + q * KSTR + hi * 16;
#pragma unroll
        for (int d0 = 0; d0 < 6; ++d0) { cA0 = MFMA32(*(const LAS bf16x8*)(kb + d0 * 32), qf[d0], cA0); cA1 = MFMA32(*(const LAS bf16x8*)(kb + 32 * KSTR + d0 * 32), qf[d0], cA1); SBAR(); }
    }
    __syncthreads();
    u32x4 ppA[4];
#pragma unroll
    for (int k = 0; k < 4; ++k) ppA[k] = (u32x4){0u, 0u, 0u, 0u};
#define MLA_LOADF(g) do { if ((g) < 8) fr[(g) % 3] = vfrag_tr(vbp + ((g) & 1) * 64 + ((g) >> 1) * 16 * VR, 8 * VR); \
                          else fr[(g) % 3] = *(const LAS bf16x8*)(kbn + ((g) & 1) * 32 * KSTR + (((g) - 8) >> 1) * 32); } while (0)
#define MLA_GAP(g, c0, c1, n0, n1, pp, pc) do { \
        if ((g) < 8) { if ((g) & 1) o1 = MFMA32(fr[(g) % 3], __builtin_bit_cast(bf16x8, pp[(g) >> 1]), o1); else o0 = MFMA32(fr[(g) % 3], __builtin_bit_cast(bf16x8, pp[(g) >> 1]), o0); } \
        else if ((g) < 10) { if ((g) & 1) n1 = MFMA32(fr[(g) % 3], qf[0], ((f32x16){0.f,0.f,0.f,0.f,0.f,0.f,0.f,0.f,0.f,0.f,0.f,0.f,0.f,0.f,0.f,0.f})); else n0 = MFMA32(fr[(g) % 3], qf[0], ((f32x16){0.f,0.f,0.f,0.f,0.f,0.f,0.f,0.f,0.f,0.f,0.f,0.f,0.f,0.f,0.f,0.f})); } \
        else { if ((g) & 1) n1 = MFMA32(fr[(g) % 3], qf[((g) - 8) >> 1], n1); else n0 = MFMA32(fr[(g) % 3], qf[((g) - 8) >> 1], n0); } \
        if ((g) + 2 < 20) MLA_LOADF((g) + 2); \
        if ((g) >= 4 && (g) < 12) { c0[2 * ((g) - 4)] = __builtin_amdgcn_exp2f(c0[2 * ((g) - 4)]); c0[2 * ((g) - 4) + 1] = __builtin_amdgcn_exp2f(c0[2 * ((g) - 4) + 1]); lsA += c0[2 * ((g) - 4)]; lsA += c0[2 * ((g) - 4) + 1]; \
            pc[((g) - 4) >> 2][((g) - 4) & 3] = pk2(c0[2 * ((g) - 4)], c0[2 * ((g) - 4) + 1]); } \
        else if ((g) >= 12) { c1[2 * ((g) - 12)] = __builtin_amdgcn_exp2f(c1[2 * ((g) - 12)]); c1[2 * ((g) - 12) + 1] = __builtin_amdgcn_exp2f(c1[2 * ((g) - 12) + 1]); lsA += c1[2 * ((g) - 12)]; lsA += c1[2 * ((g) - 12) + 1]; \
            pc[((g) - 4) >> 2][((g) - 4) & 3] = pk2(c1[2 * ((g) - 12)], c1[2 * ((g) - 12) + 1]); } \
        SBAR(); } while (0)
#define MLA_STEP(t_, c0, c1, n0, n1, pp, pc, BAR) do { \
        MLA_STK(((t_) + 3) & 3); MLA_STV(((t_) + 1) & 3); MLA_LDK((t_) + 4); MLA_LDV((t_) + 2); \
        const ldsp kbn = Kl + (((t_) + 1) & 3) * KBUF + q * KSTR + hi * 16; \
        const ldsp vbp = Vl + (((t_) + 3) & 3) * VBUF2 + vtb; \
        bf16x8 fr[3]; MLA_LOADF(0); MLA_LOADF(1); SBAR(); \
        MLA_GAP(0, c0, c1, n0, n1, pp, pc); MLA_GAP(1, c0, c1, n0, n1, pp, pc); MLA_GAP(2, c0, c1, n0, n1, pp, pc); MLA_GAP(3, c0, c1, n0, n1, pp, pc); \
        MLA_GAP(4, c0, c1, n0, n1, pp, pc); MLA_GAP(5, c0, c1, n0, n1, pp, pc); MLA_GAP(6, c0, c1, n0, n1, pp, pc); MLA_GAP(7, c0, c1, n0, n1, pp, pc); \
        MLA_GAP(8, c0, c1, n0, n1, pp, pc); MLA_GAP(9, c0, c1, n0, n1, pp, pc); MLA_GAP(10, c0, c1, n0, n1, pp, pc); MLA_GAP(11, c0, c1, n0, n1, pp, pc); \
        MLA_GAP(12, c0, c1, n0, n1, pp, pc); MLA_GAP(13, c0, c1, n0, n1, pp, pc); MLA_GAP(14, c0, c1, n0, n1, pp, pc); MLA_GAP(15, c0, c1, n0, n1, pp, pc); \
        MLA_GAP(16, c0, c1, n0, n1, pp, pc); MLA_GAP(17, c0, c1, n0, n1, pp, pc); MLA_GAP(18, c0, c1, n0, n1, pp, pc); MLA_GAP(19, c0, c1, n0, n1, pp, pc); \
        asm volatile("" : "+v"(n0), "+v"(n1), "+v"(o0), "+v"(o1));        \
        if (BAR) __syncthreads(); } while (0)
#pragma unroll 1
    for (int t = 0; t < NT; t += 2) {
        MLA_STEP(t, cA0, cA1, cB0, cB1, ppA, ppA, false);
        MLA_STEP(t + 1, cB0, cB1, cA0, cA1, ppA, ppA, true);
    }
    {
        const ldsp vb = Vl + ((NT - 1) & 3) * VBUF2 + vtb;
#pragma unroll
        for (int kk = 0; kk < 4; ++kk) { o0 = MFMA32(vfrag_tr(vb + kk * 16 * VR, 8 * VR), __builtin_bit_cast(bf16x8, ppA[kk]), o0); o1 = MFMA32(vfrag_tr(vb + 64 + kk * 16 * VR, 8 * VR), __builtin_bit_cast(bf16x8, ppA[kk]), o1); SBAR(); }
    }
    __syncthreads();
#undef MLA_LDK
#undef MLA_LDV
#undef MLA_STK
#undef MLA_STV
#undef MLA_LOADF
#undef MLA_GAP
#undef MLA_STEP
    float lsum = lsA + lsB;
    lsum = xor32_sum(lsum);
    const float il = 1.f / lsum;
    int lane2 = lane_id_v(); asm volatile("" : "+v"(lane2));
    const size_t tq2 = (size_t)b * SEQ + qb * 256 + wid * 32 + (lane2 & 31);
    bf16_t* dst = OC_ + tq2 * 1024 + 512 + h * 64 + 4 * (lane2 >> 5);
#pragma unroll
    for (int g = 0; g < 4; ++g) {
        *(u32x2*)(dst + 8 * g) = pack4((f32x4){o0[4 * g] * il, o0[4 * g + 1] * il, o0[4 * g + 2] * il, o0[4 * g + 3] * il});
        *(u32x2*)(dst + 32 + 8 * g) = pack4((f32x4){o1[4 * g] * il, o1[4 * g + 1] * il, o1[4 * g + 2] * il, o1[4 * g + 3] * il});
    }
}

DI void mla_unit_slow(ldsp lds, int b, int h, int qb, const bf16_t* Qm_, const bf16_t* Kn_, const bf16_t* Kr_, const bf16_t* Vm_, bf16_t* OC_, float ref, const int tid) {
    const int lane = tid & 63, wid = tid >> 6, q = lane & 31, hi = lane >> 5;
    const size_t tokb = (size_t)b * SEQ;
    const size_t tq = tokb + qb * 256 + wid * 32 + q;
    bf16x8 qf[6];
#pragma unroll
    for (int d0 = 0; d0 < 6; ++d0) qf[d0] = *(const bf16x8*)(Qm_ + tq * 768 + h * 96 + d0 * 16 + hi * 8);
    f32x16 o0, o1;
#pragma unroll
    for (int r = 0; r < 16; ++r) { o0[r] = 0.f; o1[r] = 0.f; }
    float lsum = 0.f;
    const int s_row = tid >> 3, s_part = tid & 7, r_row = (tid >> 2) & 63, r_part = tid & 3;
    const bf16_t* kn_src = Kn_ + (tokb + s_row) * 512 + h * 64 + s_part * 8;
    const bf16_t* v_src = Vm_ + (tokb + s_row) * 512 + h * 64 + s_part * 8;
    const bf16_t* kr_src = Kr_ + (tokb + r_row) * 32 + r_part * 8;
    const ldsp Kl = lds, Vl = lds + 2 * KBUF;
    u32x4 rk, rv, rr = (u32x4){0u, 0u, 0u, 0u};
    rk = *(const u32x4*)kn_src; rv = *(const u32x4*)v_src; if (tid < 256) rr = *(const u32x4*)kr_src;
#define MLA_STORE(buf) do { \
        *(LAS u32x4*)(Kl + (buf) * KBUF + s_row * KSTR + s_part * 16) = rk; \
        if (tid < 256) *(LAS u32x4*)(Kl + (buf) * KBUF + r_row * KSTR + 128 + r_part * 16) = rr; \
        LAS unsigned short* vt_ = (LAS unsigned short*)(Vl + (buf) * VBUF) + (s_part * 8) * (VSTR / 2) + s_row; \
        _Pragma("unroll") for (int j_ = 0; j_ < 8; ++j_) vt_[j_ * (VSTR / 2)] = (unsigned short)(rv[j_ >> 1] >> (16 * (j_ & 1))); } while (0)
    MLA_STORE(0);
    __syncthreads();
    for (int t = 0; t < SEQ / 64; ++t) {
        const int cur = t & 1;
        if (t + 1 < SEQ / 64) { const size_t off = (size_t)(t + 1) * 64;
            rk = *(const u32x4*)(kn_src + off * 512); rv = *(const u32x4*)(v_src + off * 512); if (tid < 256) rr = *(const u32x4*)(kr_src + off * 32); }
        f32x16 s0, s1;
#pragma unroll
        for (int r = 0; r < 16; ++r) { s0[r] = -ref; s1[r] = -ref; }
        const ldsp kb = Kl + cur * KBUF + q * KSTR + hi * 16;
#pragma unroll
        for (int d0 = 0; d0 < 6; ++d0) {
            const bf16x8 a0 = *(const LAS bf16x8*)(kb + d0 * 32);
            const bf16x8 a1 = *(const LAS bf16x8*)(kb + 32 * KSTR + d0 * 32);
            s0 = MFMA32(a0, qf[d0], s0); s1 = MFMA32(a1, qf[d0], s1);
        }
#pragma unroll
        for (int r = 0; r < 16; ++r) { s0[r] = __builtin_amdgcn_exp2f(s0[r]); s1[r] = __builtin_amdgcn_exp2f(s1[r]); }
        float ps = 0.f;
#pragma unroll
        for (int r = 0; r < 16; ++r) ps += s0[r] + s1[r];
        lsum += ps;
        bf16x8 pf[4]; pf[0] = pack8(s0, 0); pf[1] = pack8(s0, 1); pf[2] = pack8(s1, 0); pf[3] = pack8(s1, 1);
        const ldsp vb = Vl + cur * VBUF + q * VSTR + hi * 8;
#pragma unroll
        for (int kk = 0; kk < 4; ++kk) {
            o0 = MFMA32(vfrag(vb + kk * 32), pf[kk], o0);
            o1 = MFMA32(vfrag(vb + 32 * VSTR + kk * 32), pf[kk], o1);
        }
        if (t + 1 < SEQ / 64) MLA_STORE(cur ^ 1);
        __syncthreads();
    }
#undef MLA_STORE
    lsum = xor32_sum(lsum);
    const float il = 1.f / lsum;
    bf16_t* dst = OC_ + tq * 1024 + 512 + h * 64 + 4 * hi;
#pragma unroll
    for (int g = 0; g < 4; ++g) {
        *(u32x2*)(dst + 8 * g) = pack4((f32x4){o0[4 * g] * il, o0[4 * g + 1] * il, o0[4 * g + 2] * il, o0[4 * g + 3] * il});
        *(u32x2*)(dst + 32 + 8 * g) = pack4((f32x4){o1[4 * g] * il, o1[4 * g + 1] * il, o1[4 * g + 2] * il, o1[4 * g + 3] * il});
    }
}


constexpr int VS2 = 96;
typedef int i32x4 __attribute__((ext_vector_type(4)));
DI void dil_task(ldsp vscr, ldsp pscr, const int* pos, int cfg, int dil, int b, int h, int T0, int k, const bf16_t* Qd, const bf16_t* Kd, const bf16_t* Vd,
                 bf16_t* PART, float* LP, bf16_t* OC, float ref, float slope_l2, int lane) {
    const int tpr = 16 / dil, rs = k / tpr, sub = k % tpr, L = SEQ / dil, U0 = T0 / dil + 32 * sub;
    const int q = lane & 31, hi = lane >> 5;
    const size_t tokb = (size_t)b * SEQ;
    const size_t tq = tokb + rs + (size_t)dil * (U0 + q);
    const int lrow0 = lane >> 3, lch0 = lane & 7;
    const ldsp qscr = vscr + 32 * 192;
    {   u32x4 qc[4];
#pragma unroll
        for (int i = 0; i < 4; ++i) qc[i] = *(const u32x4*)(Qd + (tokb + rs + (size_t)dil * (U0 + 8 * i + lrow0)) * 512 + h * 64 + 8 * lch0);
#pragma unroll
        for (int i = 0; i < 4; ++i) *(LAS u32x4*)(qscr + (8 * i + lrow0) * 144 + lch0 * 16) = qc[i]; }
    bf16x8 qf[4];
#pragma unroll
    for (int d0 = 0; d0 < 4; ++d0) qf[d0] = *(const LAS bf16x8*)(qscr + q * 144 + d0 * 32 + hi * 16);
    f32x16 o0, o1;
#pragma unroll
    for (int r = 0; r < 16; ++r) { o0[r] = 0.f; o1[r] = 0.f; }
    float lsum = 0.f;
    const int posq = pos[tq];
    u32x4 kc[4], kn[4], vv[4], vvn[4]; int pk, pkn;
    const int lrow = lane >> 3, lch = lane & 7;
    const ldsp kscr = vscr + 32 * 192;
#define DIL_LOAD(KC, VV, PK, t_) do { const int Ut_ = U0 - 64 + 32 * (t_); \
        _Pragma("unroll") for (int i = 0; i < 4; ++i) { int uk_ = Ut_ + 8 * i + lrow; uk_ = uk_ < 0 ? 0 : (uk_ > L - 1 ? L - 1 : uk_); \
            const size_t tk_ = tokb + rs + (size_t)dil * uk_; \
            KC[i] = *(const u32x4*)(Kd + tk_ * 512 + h * 64 + 8 * lch); VV[i] = *(const u32x4*)(Vd + tk_ * 512 + h * 64 + 8 * lch); } \
        { int ukl_ = Ut_ + q; ukl_ = ukl_ < 0 ? 0 : (ukl_ > L - 1 ? L - 1 : ukl_); PK = pos[tokb + rs + (size_t)dil * ukl_]; } } while (0)
    DIL_LOAD(kc, vv, pk, 0);
#pragma unroll 1
    for (int t = 0; t < 5; ++t) {
        const int Ut = U0 - 64 + 32 * t;
        if (t < 4) DIL_LOAD(kn, vvn, pkn, t + 1);
        if (!(Ut + 31 < 0 || Ut >= L)) {
#pragma unroll
        for (int i = 0; i < 4; ++i) { *(LAS u32x4*)(vscr + (8 * i + lrow) * 192 + lch * 16) = vv[i]; *(LAS u32x4*)(kscr + (8 * i + lrow) * 144 + lch * 16) = kc[i]; }
        f32x16 s;
#pragma unroll
        for (int r = 0; r < 16; ++r) s[r] = -ref;
#pragma unroll
        for (int d0 = 0; d0 < 4; ++d0) s = MFMA32(*(const LAS bf16x8*)(kscr + q * 144 + d0 * 32 + hi * 16), qf[d0], s);
        float ps = 0.f;
        if (hi == 0) ((LAS int*)pscr)[q] = pk;
        i32x4 pk4[4];
#pragma unroll
        for (int g = 0; g < 4; ++g) pk4[g] = *(const LAS i32x4*)(pscr + (8 * g + 4 * hi) * 4);
        const float fbase = (float)(Ut - U0 - q + 4 * hi);
        if ((Ut >= 0) && (Ut + 31 < L) && t >= 1 && t <= 3) {
#pragma unroll
            for (int r = 0; r < 16; ++r) {
                const float dist = (float)(pk4[r >> 2][r & 3] - posq);
                const float p = __builtin_amdgcn_exp2f(__builtin_fmaf(-slope_l2, __builtin_fabsf(dist), s[r]));
                s[r] = p; ps += p;
            }
        } else if ((Ut >= 0) && (Ut + 31 < L)) {
#pragma unroll
            for (int r = 0; r < 16; ++r) {
                const float fd = fbase + (float)((r & 3) + 8 * (r >> 2));
                const float dist = (float)(pk4[r >> 2][r & 3] - posq);
                const float e = __builtin_amdgcn_exp2f(__builtin_fmaf(-slope_l2, __builtin_fabsf(dist), s[r]));
                const float p = (__builtin_fabsf(fd) <= 64.f) ? e : 0.f;
                s[r] = p; ps += p;
            }
        } else {
#pragma unroll
            for (int r = 0; r < 16; ++r) {
                const int uk = Ut + crow(r, hi);
                const float fd = fbase + (float)((r & 3) + 8 * (r >> 2));
                const float dist = (float)(pk4[r >> 2][r & 3] - posq);
                const float e = __builtin_amdgcn_exp2f(__builtin_fmaf(-slope_l2, __builtin_fabsf(dist), s[r]));
                const float p = ((__builtin_fabsf(fd) <= 64.f) && (uk >= 0) && (uk < L)) ? e : 0.f;
                s[r] = p; ps += p;
            }
        }
        lsum += ps;
        const bf16x8 pf0 = pack8(s, 0), pf1 = pack8(s, 1);
        const ldsp vb = vscr + (4 * hi + ((lane & 15) >> 2)) * 192 + (16 * ((lane >> 4) & 1) + 4 * (lane & 3)) * 2;
        o0 = MFMA32(vfrag_tr(vb, 8 * 192), pf0, o0);
        o0 = MFMA32(vfrag_tr(vb + 16 * 192, 8 * 192), pf1, o0);
        o1 = MFMA32(vfrag_tr(vb + 64, 8 * 192), pf0, o1);
        o1 = MFMA32(vfrag_tr(vb + 64 + 16 * 192, 8 * 192), pf1, o1);
        }
#pragma unroll
        for (int i = 0; i < 4; ++i) { kc[i] = kn[i]; vv[i] = vvn[i]; }
        pk = pkn;
    }
#undef DIL_LOAD
    lsum = xor32_sum(lsum);
    {
        const ldsp oscr = vscr;
#pragma unroll
        for (int g = 0; g < 4; ++g) {
            *(LAS f32x4*)(oscr + q * 272 + (8 * g + 4 * hi) * 4) = (f32x4){o0[4 * g], o0[4 * g + 1], o0[4 * g + 2], o0[4 * g + 3]};
            *(LAS f32x4*)(oscr + q * 272 + (32 + 8 * g + 4 * hi) * 4) = (f32x4){o1[4 * g], o1[4 * g + 1], o1[4 * g + 2], o1[4 * g + 3]};
        }
        if (hi == 0) ((LAS float*)(oscr + 8704))[q] = lsum;
#pragma unroll
        for (int i = 0; i < 4; ++i) {
            const int row = 8 * i + lrow0;
            const size_t tr = tokb + rs + (size_t)dil * (U0 + row);
            const f32x4 a0 = *(const LAS f32x4*)(oscr + row * 272 + lch0 * 32), a1 = *(const LAS f32x4*)(oscr + row * 272 + lch0 * 32 + 16);
            const float lrw = ((const LAS float*)(oscr + 8704))[row];
            if (cfg < 2) {
                u32x4 w; w.x = pk2(a0[0], a0[1]); w.y = pk2(a0[2], a0[3]); w.z = pk2(a1[0], a1[1]); w.w = pk2(a1[2], a1[3]);
                *(u32x4*)(PART + ((size_t)cfg * MTOK + tr) * 512 + h * 64 + 8 * lch0) = w;
                if (lch0 == 0) LP[((size_t)cfg * MTOK + tr) * 8 + h] = lrw;
            } else {
                const u32x4 p0 = *(const u32x4*)(PART + tr * 512 + h * 64 + 8 * lch0), p1 = *(const u32x4*)(PART + ((size_t)MTOK + tr) * 512 + h * 64 + 8 * lch0);
                const float il = 1.f / (lrw + LP[tr * 8 + h] + LP[((size_t)MTOK + tr) * 8 + h]);
                float v[8];
#pragma unroll
                for (int e = 0; e < 8; ++e) { const unsigned aw = p0[e >> 1], cw = p1[e >> 1];
                    const float av = __uint_as_float((e & 1) ? (aw & 0xffff0000u) : (aw << 16)), cv = __uint_as_float((e & 1) ? (cw & 0xffff0000u) : (cw << 16));
                    v[e] = ((e < 4 ? a0[e & 3] : a1[e & 3]) + av + cv) * il; }
                u32x4 w; w.x = pk2(v[0], v[1]); w.y = pk2(v[2], v[3]); w.z = pk2(v[4], v[5]); w.w = pk2(v[6], v[7]);
                *(u32x4*)(OC + tr * 1024 + h * 64 + 8 * lch0) = w;
            }
        }
    }
}

__global__ void __launch_bounds__(NTHREADS, 2) mega_fwd(Params P) {
    extern __shared__ __attribute__((aligned(16))) unsigned char lds_raw[];
    cg::grid_group grid = cg::this_grid();
    const ldsp lds = (ldsp)lds_raw;
    const int G0 = gridDim.x, blk0 = blockIdx.x;
    const int wid_s = __builtin_amdgcn_readfirstlane((int)threadIdx.x >> 6);
    { int lane0 = lane_id_v(); const int tid0 = wid_s * 64 + lane0;
      volatile LAS unsigned* st = (volatile LAS unsigned*)(lds + LDS_BYTES - 16);
      if (tid0 == 0) { st[0] = 0u; st[1] = 0u; }
      __syncthreads();
      (void)xcd_barrier_post((unsigned*)(PF(ws) + WS_BAR), st, tid0); }
#define GSYNC() do { int w_ = wid_s; asm volatile("" : "+s"(w_)); int l_ = lane_id_v(); asm volatile("" : "+v"(l_)); \
    XcdBarrier xb_; xb_.bar = (unsigned*)(PF(ws) + WS_BAR); xb_.x = xb_xcc_id(); xb_.st = (volatile LAS unsigned*)(lds + LDS_BYTES - 16); xcd_barrier(xb_, w_ * 64 + l_); } while (0)
#define PHASE_BEGIN() int blk = blk0, G = G0; asm volatile("" : "+s"(blk), "+s"(G)); int wid = wid_s; asm volatile("" : "+s"(wid)); int lane = lane_id_v(); asm volatile("" : "+v"(lane)); const int tid = wid * 64 + lane; \
    unsigned long long wsv_ = karg_u64((int)__builtin_offsetof(Params, ws)); asm volatile("" : "+s"(wsv_)); unsigned char* ws = gptr<unsigned char>(wsv_); const int gw = blk * 8 + wid, NGW = G * 8; (void)lane; (void)gw; (void)NGW
#define MOD ((float*)(ws + WS_MOD))
#define BIAS1 ((float*)(ws + WS_BIAS1))
#define BIAS2 ((float*)(ws + WS_BIAS2))
#define GS1 ((float*)(ws + WS_GS1))
#define GS2 ((float*)(ws + WS_GS2))
#define XA ((bf16_t*)(ws + WS_XA))
#define Qd ((bf16_t*)(ws + WS_QD))
#define Kd ((bf16_t*)(ws + WS_KD))
#define Vd ((bf16_t*)(ws + WS_VD))
#define Qm ((bf16_t*)(ws + WS_QM))
#define Kn ((bf16_t*)(ws + WS_KN))
#define Vm ((bf16_t*)(ws + WS_VM))
#define OC ((bf16_t*)(ws + WS_OC))
#define Kr ((bf16_t*)(ws + WS_KR))
#define CQ ((bf16_t*)(ws + WS_CQ))
#define CKV ((bf16_t*)(ws + WS_CKV))
#define PART ((bf16_t*)(ws + WS_PART))
#define LP ((float*)(ws + WS_LP))
#define SSQX ((float*)(ws + WS_SSQX))
#define SSQ2 ((float*)(ws + WS_SSQ2))
#define SSQCQ ((float*)(ws + WS_SSQCQ))
#define SSQCKV ((float*)(ws + WS_SSQCKV))
#define HB ((bf16_t*)(ws + WS_H))
#define RCOS ((float*)(ws + WS_RCOS))
#define RSIN ((float*)(ws + WS_RSIN))
#define WL(off) (ws + WS_W + (size_t)l * WS_WSTRIDE + (off))

    {
    PHASE_BEGIN();
    LAS float* vecs = (LAS float*)lds; LAS float* red = (LAS float*)(lds + 8192); LAS float* tscr = (LAS float*)(lds + 16384 + wid * 8704);
    if ((PH_MASK & 1) && (blk < 192 || G < 192)) {
        for (int i = tid; i < 2048; i += NTHREADS) { const float cv = PF(c)[i]; vecs[i] = cv / (1.f + __expf(-cv)); }
        __syncthreads();
        for (int u = blk; u < 192; u += G) { const int l = u / 96, nb = u % 96;
            gemv_unit(PF(w_mod) + (size_t)l * DM * 6144, 6144, 6144, nb, vecs, red, MOD + (l * 2 + 0) * 6144, MOD + (l * 2 + 1) * 6144, PF(b_mod) + l * 6144, tid); }
    }
    for (int i = blk * NTHREADS + tid; i < MTOK * 16; i += G * NTHREADS) {
        float sn, cs; sincos_rev((float)PF(pos)[i >> 4] * c_inv[i & 15], sn, cs); RCOS[i] = cs; RSIN[i] = sn; }
    if (PH_MASK & 2) {
        constexpr int I_IN = 16 * 64, I_QU = 4 * 24, I_KV = 2 * 32, I_OUT = 16 * 32, I_W1 = 16 * 128, I_W2 = 64 * 32, I_L = I_IN + I_QU + I_KV + I_OUT + I_W1 + I_W2;
        for (int it = gw; it < 2 * I_L; it += NGW) {
            const int l = it / I_L; int r = it % I_L;
            unsigned char* wl = ws + WS_W + (size_t)l * WS_WSTRIDE;
            if (r < I_IN) { transpose_item(PF(w_in) + (size_t)l * DM * WIN_COLS, DM, WIN_COLS, 64, (bf16_t*)(wl + WO_IN), nullptr, tscr, r, lane,
                    [](int Gp) { const int pn = Gp >> 3, bj = (Gp >> 2) & 1, wc = Gp & 3; const int lb = 256 * pn + 64 * wc + 32 * bj; return lb < WIN_COLS ? lb : -1; }); continue; }
            r -= I_IN;
            if (r < I_QU) { transpose_item(PF(w_q_up) + (size_t)l * 256 * 768, 256, 768, 24, (bf16_t*)(wl + WO_QU), PF(g_cq) + l * 256, tscr, r, lane,
                    [](int Gp) { const int pn = Gp >> 3, bj = (Gp >> 2) & 1, wc = Gp & 3; return pn < 2 ? (4 * pn + wc) * 96 + 32 * bj : (2 * wc + bj) * 96 + 64; }); continue; }
            r -= I_QU;
            if (r < I_KV) { transpose_item(PF(w_kv_up) + (size_t)l * 128 * 1024, 128, 1024, 32, (bf16_t*)(wl + WO_KV), PF(g_ckv) + l * 128, tscr, r, lane,
                    [](int Gp) { const int pn = Gp >> 3, bj = (Gp >> 2) & 1, wc = Gp & 3; return pn < 2 ? (4 * pn + wc) * 128 + 32 * bj : (4 * (pn - 2) + wc) * 128 + 64 + 32 * bj; }); continue; }
            r -= I_KV;
            if (r < I_OUT) { transpose_item(PF(w_out) + (size_t)l * DM * DM, DM, DM, 32, (bf16_t*)(wl + WO_OUT), nullptr, tscr, r, lane, [](int Gp) { return 32 * Gp; }); continue; }
            r -= I_OUT;
            if (r < I_W1) { transpose_item(PF(w_mlp_in) + (size_t)l * DM * FF, DM, FF, 128, (bf16_t*)(wl + WO_W1), nullptr, tscr, r, lane, [](int Gp) { return 32 * Gp; }); continue; }
            r -= I_W1;
            transpose_item(PF(w_mlp_out) + (size_t)l * FF * DM, FF, DM, 32, (bf16_t*)(wl + WO_W2), nullptr, tscr, r, lane, [](int Gp) { return 32 * Gp; });
        }
    }
    }
    GSYNC();
    if (G0 > (1 << 24)) grid.sync();

    {
    PHASE_BEGIN();
    LAS float* vecs = (LAS float*)lds; LAS float* red = (LAS float*)(lds + 8192);
    if (PH_MASK & 4) for (int u = blk; u < 192; u += G) {
        const int l = u / 96, rem = u % 96; const bool first = rem < 32;
        const int sh_off = first ? 0 : 3072;
        __syncthreads();
        for (int i = tid; i < 2048; i += NTHREADS) vecs[i] = MOD[(l * 2 + (i >> 10)) * 6144 + sh_off + (i & 1023)];
        __syncthreads();
        if (first) gemv_unit(PF(w_in) + (size_t)l * DM * WIN_COLS, WIN_COLS, WIN_PAD, rem, vecs, red, BIAS1 + (l * 2 + 0) * WIN_PAD, BIAS1 + (l * 2 + 1) * WIN_PAD, nullptr, tid);
        else gemv_unit(PF(w_mlp_in) + (size_t)l * DM * FF, FF, FF, rem - 32, vecs, red, BIAS2 + (l * 2 + 0) * FF, BIAS2 + (l * 2 + 1) * FF, nullptr, tid);
    }
    if (blk == G - 1 && tid < 2) {
        const int l = tid;
        float Gq = 0.f, Gk = 0.f, Gqn = 0.f, Gkn = 0.f, Gqr = 0.f, Gkr = 0.f;
#pragma unroll 1
        for (int i = 0; i < 64; ++i) { Gq = fmaxf(Gq, fabsf(PF(g_q_dil)[l * 64 + i])); Gk = fmaxf(Gk, fabsf(PF(g_k_dil)[l * 64 + i]));
            Gqn = fmaxf(Gqn, fabsf(PF(g_q_nope)[l * 64 + i])); Gkn = fmaxf(Gkn, fabsf(PF(g_k_nope)[l * 64 + i])); }
#pragma unroll 1
        for (int i = 0; i < 32; ++i) { Gqr = fmaxf(Gqr, fabsf(PF(g_q_rope)[l * 32 + i])); Gkr = fmaxf(Gkr, fabsf(PF(g_k_rope)[l * 32 + i])); }
        ((float*)(ws + WS_REFS))[l * 2 + 0] = 64.f * Gq * Gk * QS_D;
        ((float*)(ws + WS_REFS))[l * 2 + 1] = (64.f * Gqn * Gkn + 32.f * Gqr * Gkr) * QS_M;
    }
    for (int i = blk * NTHREADS + tid; i < 4096; i += G * NTHREADS) {
        const int lb = i >> 10, c = i & 1023, l = lb >> 1;
        GS1[i] = PF(g_norm_mix)[l * DM + c] * (1.f + MOD[lb * 6144 + 1024 + c]);
        GS2[i] = PF(g_norm_mlp)[l * DM + c] * (1.f + MOD[lb * 6144 + 4096 + c]);
    }
    for (int m0 = 4 * gw; m0 < MTOK; m0 += 4 * NGW) {
        f32x4 xv[4][4];
#pragma unroll
        for (int r = 0; r < 4; ++r)
#pragma unroll
            for (int j = 0; j < 4; ++j) xv[r][j] = *(const f32x4*)(PF(x) + (size_t)(m0 + r) * DM + 4 * lane + 256 * j);
        const int b = m0 >> 13;
#pragma unroll
        for (int r = 0; r < 4; ++r) { const int m = m0 + r; float s = 0.f;
#pragma unroll
            for (int j = 0; j < 4; ++j) { const int c = 4 * lane + 256 * j;
                const f32x4 v = xv[r][j], gg = *(const f32x4*)(PF(g_norm_mix) + c), sc = *(const f32x4*)(MOD + b * 6144 + 1024 + c);
                s += sq4(v); *(u32x2*)(XA + (size_t)m * DM + c) = pack4(v * gg * (sc + 1.f)); }
            s = wave_sum(s);
            if (lane < 16) SSQX[(size_t)m * 16 + lane] = lane == 0 ? s : 0.f; }
    }
    }
    GSYNC();

#pragma unroll 1
    for (int l = 0; l < 2; ++l) {
        if (PH_MASK & 8) {
            PHASE_BEGIN();
            pg8::Gemm g{XA, (const bf16_t*)WL(WO_IN), MTOK, WIN_PAD, DM}; pg8::StaticOrder S; S.init(MTOK, WIN_PAD, G, blk);
            EpiIn E{ws, BIAS1 + (size_t)l * 2 * WIN_PAD, PF(g_q_dil) + l * 64, PF(g_k_dil) + l * 64, PF(g_k_rope) + l * 32};
            pg8::gemm_phase<EpiIn, pg8::StaticOrder, true, true>(lds, g, S, E, tid);
        }
        GSYNC();
        if (PH_MASK & 16) {
            PHASE_BEGIN();
            int Kq = 256; asm volatile("" : "+s"(Kq));
            pg8::Gemm g{CQ, (const bf16_t*)WL(WO_QU), MTOK, 768, Kq}; pg8::StaticOrder S; S.init(MTOK, 768, G, blk);
            EpiQup E{SSQCQ, PF(g_q_nope) + l * 64, PF(g_q_rope) + l * 32, RCOS, RSIN, Qm};
            pg8::gemm_phase<EpiQup, pg8::StaticOrder, true, true>(lds, g, S, E, tid);
        }
        __syncthreads();
        if (PH_MASK & 32) {
            PHASE_BEGIN();
            int Kk = 128; asm volatile("" : "+s"(Kk));
            pg8::Gemm g{CKV, (const bf16_t*)WL(WO_KV), MTOK, 1024, Kk}; pg8::StaticOrder S; S.init(MTOK, 1024, G, blk);
            EpiKvup E{SSQCKV, PF(g_k_nope) + l * 64, Kn, Vm};
            pg8::gemm_phase<EpiKvup, pg8::StaticOrder, true, true>(lds, g, S, E, tid);
        }
        GSYNC();
        {
            PHASE_BEGIN();
            const float ref_d = ((const float*)(ws + WS_REFS))[l * 2 + 0], ref_m = ((const float*)(ws + WS_REFS))[l * 2 + 1];
            if (PH_MASK & 64) for (int u = blk; u < 256; u += G) {
                const int h = u & 7, tb = (u >> 3) & 15, b = u >> 7;
                const float slope_l2 = LOG2E / (float)(1 << (h + 1));
                const ldsp vscr = lds + wid * 10752;
#pragma unroll 1
                for (int cfg = 0; cfg < 3; ++cfg) {
                    if (cfg == 2) __syncthreads();
                    const int dil = cfg == 0 ? 1 : (cfg == 1 ? 4 : 16);
#pragma unroll 1
                    for (int k = wid; k < 16; k += 8) dil_task(vscr, lds + 8 * 10752 + wid * 128, PF(pos), cfg, dil, b, h, tb * 512, k, Qd, Kd, Vd, PART, LP, OC, ref_d, slope_l2, lane);
                }
                __syncthreads();
            }
            if (ref_m < 100.f) {
                for (int u = blk; u < 512; u += G) { const int x = u & 7, j = (u >> 3) & 31, i = u >> 8, bh = 2 * x + i;
                    mla_unit(lds, bh >> 3, bh & 7, j, Qm, Kn, Kr, Vm, OC, 0.f, wid); }
            } else {
                for (int u = blk; u < 512; u += G) { const int x = u & 7, j = (u >> 3) & 31, i = u >> 8, bh = 2 * x + i;
                    mla_unit_slow(lds, bh >> 3, bh & 7, j, Qm, Kn, Kr, Vm, OC, ref_m, tid); }
            }
        }
        GSYNC();
        if (PH_MASK & 256) {
            PHASE_BEGIN();
            pg8::Gemm g{OC, (const bf16_t*)WL(WO_OUT), MTOK, DM, DM}; pg8::StaticOrder S; S.init(MTOK, DM, G, blk);
            EpiRes E{l == 0 ? PF(x) : (const float*)PF(out), PF(out), MOD + (size_t)l * 2 * 6144 + 2048, GS2 + (size_t)l * 2 * DM, XA, SSQ2};
            pg8::gemm_phase<EpiRes, pg8::StaticOrder, true, true>(lds, g, S, E, tid);
        }
        GSYNC();
        if (PH_MASK & 512) {
            PHASE_BEGIN();
            pg8::Gemm g{XA, (const bf16_t*)WL(WO_W1), MTOK, FF, DM}; pg8::StaticOrder S; S.init(MTOK, FF, G, blk);
            EpiUp E{SSQ2, BIAS2 + (size_t)l * 2 * FF, HB};
            pg8::gemm_phase<EpiUp, pg8::StaticOrder, true, true>(lds, g, S, E, tid);
        }
        GSYNC();
        if (PH_MASK & 1024) {
            PHASE_BEGIN();
            pg8::Gemm g{HB, (const bf16_t*)WL(WO_W2), MTOK, DM, FF}; pg8::StaticOrder S; S.init(MTOK, DM, G, blk);
            EpiRes E{(const float*)PF(out), PF(out), MOD + (size_t)l * 2 * 6144 + 5120, l == 0 ? GS1 + 2 * DM : nullptr, XA, SSQX};
            pg8::gemm_phase<EpiRes, pg8::StaticOrder, true, true>(lds, g, S, E, tid);
        }
        if (l == 0) GSYNC();
    }
}

extern "C" void kernel_launch(void* const* d_in, const int* in_sizes, int n_in, void* d_out, int out_size, void* d_ws, size_t ws_size, hipStream_t stream) {
    static int grid = 0;
    if (grid == 0) {
        if (n_in != 21 || ws_size < WS_END) { fprintf(stderr, "kernel_launch: unexpected n_in %d / ws_size %zu\n", n_in, ws_size); grid = -1; return; }
        int dev = 0, cus = 0, per_cu = 0;
        hipGetDevice(&dev);
        hipDeviceGetAttribute(&cus, hipDeviceAttributeMultiprocessorCount, dev);
        if (hipFuncSetAttribute((const void*)mega_fwd, hipFuncAttributeMaxDynamicSharedMemorySize, LDS_BYTES) != hipSuccess) { fprintf(stderr, "kernel_launch: hipFuncSetAttribute failed\n"); }
        if (hipOccupancyMaxActiveBlocksPerMultiprocessor(&per_cu, (const void*)mega_fwd, NTHREADS, LDS_BYTES) != hipSuccess || per_cu < 1) { fprintf(stderr, "kernel_launch: occupancy query says %d\n", per_cu); per_cu = 1; }
        (void)hipGetLastError();
        grid = cus;
        if (grid > 256) grid = 256;
    }
    if (grid < 0) return;
    Params p{};
    p.x = (const float*)d_in[0]; p.c = (const float*)d_in[1]; p.pos = (const int*)d_in[2]; p.w_mod = (const float*)d_in[3]; p.b_mod = (const float*)d_in[4];
    p.g_norm_mix = (const float*)d_in[5]; p.w_in = (const float*)d_in[6]; p.g_q_dil = (const float*)d_in[7]; p.g_k_dil = (const float*)d_in[8]; p.g_cq = (const float*)d_in[9];
    p.w_q_up = (const float*)d_in[10]; p.g_ckv = (const float*)d_in[11]; p.w_kv_up = (const float*)d_in[12]; p.g_q_nope = (const float*)d_in[13]; p.g_q_rope = (const float*)d_in[14];
    p.g_k_nope = (const float*)d_in[15]; p.g_k_rope = (const float*)d_in[16]; p.w_out = (const float*)d_in[17]; p.g_norm_mlp = (const float*)d_in[18];
    p.w_mlp_in = (const float*)d_in[19]; p.w_mlp_out = (const float*)d_in[20]; p.out = (float*)d_out; p.ws = (unsigned char*)d_ws;
    if (hipMemsetAsync((char*)d_ws + WS_BAR, 0, WS_BAR_BYTES, stream) != hipSuccess) { fprintf(stderr, "kernel_launch: memset failed\n"); return; }
    void* args[] = {&p};
    hipError_t e = hipLaunchCooperativeKernel((const void*)mega_fwd, dim3(grid), dim3(NTHREADS), args, LDS_BYTES, stream);
    if (e != hipSuccess) fprintf(stderr, "kernel_launch: cooperative launch failed: %s (grid %d)\n", hipGetErrorString(e), grid);
}
```
